# Optimizing an MI355X kernel written in HIP

```python
import math
import jax, jax.numpy as jnp
from jax import lax
import numpy as np

D_MODEL = 1024
BATCH = 16
SEQ = 2048
DEPTH = 4

GRID_W = 64
CTX_LEN = 256
N_EVEN = (DEPTH + 1) // 2
N_ODD = DEPTH // 2
N_MOD = 6
A_HEAD_DIM = 64
A_HEADS = D_MODEL // A_HEAD_DIM
A_KV_HEADS = A_HEADS // 4
A_GROUP = A_HEADS // A_KV_HEADS
WINDOW = 128
BLOCK = 128
B_HEAD_DIM = 64
B_V_DIM = 2 * B_HEAD_DIM
B_HEADS = D_MODEL // B_V_DIM
D_FF = 2816
N_EXPERTS = 8
TOP_K = 2
D_FF_EXPERT = 3584
ROPE_THETA = 10000.0
LN_EPS = 1e-5
RMS_EPS = 1e-5
NEG_INF = -1e30
DEEPNORM_ALPHA = (2.0 * DEPTH) ** 0.25
DEEPNORM_BETA = (8.0 * DEPTH) ** -0.25
MOD_INIT_SCALE = 0.2

kernel_name = 'hybrid_interleaved_swa_diffattn_moe_dit'


def layer_norm(x, g, b):
    xf = x.astype(jnp.float32)
    mu = jnp.mean(xf, axis=-1, keepdims=True)
    var = jnp.mean(jnp.square(xf - mu), axis=-1, keepdims=True)
    y = (xf - mu) * lax.rsqrt(var + LN_EPS)
    return (y * g.astype(jnp.float32) + b.astype(jnp.float32)).astype(x.dtype)


def rms_norm(x, g):
    xf = x.astype(jnp.float32)
    y = xf * lax.rsqrt(jnp.mean(xf * xf, axis=-1, keepdims=True) + RMS_EPS)
    return (y * g.astype(jnp.float32)).astype(x.dtype)


def axial_rope_tables(n_tokens, head_dim, dtype):
    rows = n_tokens // GRID_W
    row = jnp.repeat(jnp.arange(rows, dtype=jnp.float32), GRID_W)
    col = jnp.tile(jnp.arange(GRID_W, dtype=jnp.float32), rows)
    half = head_dim // 2
    inv = ROPE_THETA ** (-jnp.arange(0, half, 2, dtype=jnp.float32) / half)
    ang_r = row[:, None] * inv[None, :]
    ang_c = col[:, None] * inv[None, :]
    ang = jnp.concatenate([ang_r, ang_r, ang_c, ang_c], axis=-1)
    return jnp.cos(ang).astype(dtype), jnp.sin(ang).astype(dtype)


def apply_axial_rope(x, cos, sin):
    x1, x2, x3, x4 = jnp.split(x, 4, axis=-1)
    rot = jnp.concatenate([-x2, x1, -x4, x3], axis=-1)
    return x * cos[None, :, None, :] + rot * sin[None, :, None, :]


def modulation(cond, w_mod, b_mod):
    m = jnp.dot(jax.nn.silu(cond), w_mod) + b_mod
    return jnp.split(m, N_MOD, axis=-1)


def split_heads(t, n_heads, head_dim):
    return t.reshape(t.shape[0], t.shape[1], n_heads, head_dim)


def windowed_gqa(hl, hc, w_qkv, sink, w_o, cos, sin, with_ctx):
    B, L, _ = hl.shape
    qd = A_HEADS * A_HEAD_DIM
    kd = A_KV_HEADS * A_HEAD_DIM

    def proj(h):
        q, k, v = jnp.split(h @ w_qkv, [qd, qd + kd], axis=-1)
        return (split_heads(q, A_HEADS, A_HEAD_DIM), split_heads(k, A_KV_HEADS, A_HEAD_DIM),
                split_heads(v, A_KV_HEADS, A_HEAD_DIM))

    ql, kl, vl = proj(hl)
    qc, kc, vc = proj(hc)
    ql = apply_axial_rope(ql, cos, sin)
    kl = apply_axial_rope(kl, cos, sin)
    scale = A_HEAD_DIM ** -0.5
    nb = L // BLOCK

    qb = ql.reshape(B, nb, BLOCK, A_KV_HEADS, A_GROUP, A_HEAD_DIM)
    pad = ((0, 0), (BLOCK, BLOCK), (0, 0), (0, 0))
    kp = jnp.pad(kl, pad).reshape(B, nb + 2, BLOCK, A_KV_HEADS, A_HEAD_DIM)
    vp = jnp.pad(vl, pad).reshape(B, nb + 2, BLOCK, A_KV_HEADS, A_HEAD_DIM)
    kband = jnp.concatenate([kp[:, :-2], kp[:, 1:-1], kp[:, 2:]], axis=2)
    vband = jnp.concatenate([vp[:, :-2], vp[:, 1:-1], vp[:, 2:]], axis=2)

    qpos = jnp.arange(L).reshape(nb, BLOCK)
    kpos = (jnp.arange(nb)[:, None] - 1) * BLOCK + jnp.arange(3 * BLOCK)[None, :]
    rel = kpos[:, None, :] - qpos[:, :, None]
    band_mask = (jnp.abs(rel) <= WINDOW) & (kpos[:, None, :] >= 0) & (kpos[:, None, :] < L)

    s_band = jnp.einsum('bnqhgd,bnkhd->bnhgqk', qb, kband).astype(jnp.float32) * scale
    s_band = jnp.where(band_mask[None, :, None, None], s_band, NEG_INF)
    s_ctx = jnp.einsum('bnqhgd,bchd->bnhgqc', qb, kc).astype(jnp.float32) * scale
    sink_g = sink.astype(jnp.float32).reshape(A_KV_HEADS, A_GROUP, 1, 1)
    s_sink = jnp.broadcast_to(sink_g, s_band.shape[:-1] + (1,))
    p = jax.nn.softmax(jnp.concatenate([s_band, s_ctx, s_sink], axis=-1), axis=-1)
    p_band = p[..., :3 * BLOCK].astype(vl.dtype)
    p_ctx = p[..., 3 * BLOCK:3 * BLOCK + kc.shape[1]].astype(vl.dtype)
    ol = (jnp.einsum('bnhgqk,bnkhd->bnqhgd', p_band, vband)
          + jnp.einsum('bnhgqc,bchd->bnqhgd', p_ctx, vc))
    ol = ol.reshape(B, L, qd) @ w_o

    oc = None
    if with_ctx:
        C = hc.shape[1]
        qcg = qc.reshape(B, C, A_KV_HEADS, A_GROUP, A_HEAD_DIM)
        s = jnp.einsum('bqhgd,bkhd->bhgqk', qcg, kc).astype(jnp.float32) * scale
        s_sink_c = jnp.broadcast_to(sink_g, s.shape[:-1] + (1,))
        pc = jax.nn.softmax(jnp.concatenate([s, s_sink_c], axis=-1), axis=-1)
        oc = jnp.einsum('bhgqk,bkhd->bqhgd', pc[..., :C].astype(vc.dtype), vc)
        oc = oc.reshape(B, C, qd) @ w_o
    return ol, oc


def diff_core(q, k, v, lam, subln_g, lam_init):
    n = q.shape[1]
    s = jnp.einsum('bqhd,bkhd->bhqk', q, k).astype(jnp.float32) * (B_HEAD_DIM ** -0.5)
    p = jax.nn.softmax(s, axis=-1).reshape(q.shape[0], B_HEADS, 2, n, k.shape[1])
    a = (p[:, :, 0] - lam * p[:, :, 1]).astype(v.dtype)
    o = jnp.einsum('bhqk,bkhd->bqhd', a, v)
    return rms_norm(o, subln_g) * (1.0 - lam_init)


def diff_attention(hl, hc, w_qkv, lam_q1, lam_k1, lam_q2, lam_k2, subln_g, w_o, cos, sin, lam_init, with_ctx):
    B, L, _ = hl.shape
    qd = 2 * B_HEADS * B_HEAD_DIM

    def proj(h):
        q, k, v = jnp.split(h @ w_qkv, [qd, 2 * qd], axis=-1)
        return (split_heads(q, 2 * B_HEADS, B_HEAD_DIM), split_heads(k, 2 * B_HEADS, B_HEAD_DIM),
                split_heads(v, B_HEADS, B_V_DIM))

    ql, kl, vl = proj(hl)
    qc, kc, vc = proj(hc)
    ql = apply_axial_rope(ql, cos, sin)
    kl = apply_axial_rope(kl, cos, sin)
    lam = (jnp.exp(jnp.sum(lam_q1.astype(jnp.float32) * lam_k1.astype(jnp.float32)))
           - jnp.exp(jnp.sum(lam_q2.astype(jnp.float32) * lam_k2.astype(jnp.float32))) + lam_init)

    k_all = jnp.concatenate([kl, kc], axis=1)
    v_all = jnp.concatenate([vl, vc], axis=1)
    nb = L // BLOCK
    qb = ql.reshape(B, nb, BLOCK, 2 * B_HEADS, B_HEAD_DIM).swapaxes(0, 1)
    ob = lax.map(lambda q: diff_core(q, k_all, v_all, lam, subln_g, lam_init), qb)
    ol = ob.swapaxes(0, 1).reshape(B, L, B_HEADS * B_V_DIM) @ w_o

    oc = None
    if with_ctx:
        oc = diff_core(qc, kc, vc, lam, subln_g, lam_init)
        oc = oc.reshape(B, hc.shape[1], B_HEADS * B_V_DIM) @ w_o
    return ol, oc


def swiglu(h, w_g, w_u, w_d):
    return (jax.nn.silu(h @ w_g) * (h @ w_u)) @ w_d


def moe_swiglu(h, w_router, w_g, w_u, w_d):
    shp = h.shape
    t = h.reshape(-1, shp[-1])
    logits = (t @ w_router).astype(jnp.float32)
    top_v, top_i = lax.top_k(logits, TOP_K)
    top_w = jax.nn.softmax(top_v, axis=-1)
    gates = jnp.sum(jax.nn.one_hot(top_i, N_EXPERTS, dtype=jnp.float32) * top_w[..., None], axis=1).astype(h.dtype)
    y = jnp.zeros_like(t)
    for e in range(N_EXPERTS):
        y = y + gates[:, e:e + 1] * swiglu(t, w_g[e], w_u[e], w_d[e])
    return y.reshape(shp)


def setup_inputs(seed: int = 0) -> dict:
    key = jax.random.key(seed)
    ks = iter(jax.random.split(key, 32))

    def nrm(shape, scale):
        return jax.random.normal(next(ks), shape, jnp.float32) * scale

    D = D_MODEL
    s = D ** -0.5
    a_qd = A_HEADS * A_HEAD_DIM
    a_kd = A_KV_HEADS * A_HEAD_DIM
    b_qd = 2 * B_HEADS * B_HEAD_DIM
    b_vd = B_HEADS * B_V_DIM
    x = nrm((BATCH, SEQ, D), 1.0)
    c = nrm((BATCH, D), 1.0)
    ctx = nrm((BATCH, CTX_LEN, D), 1.0)
    c_ctx = nrm((D,), 1.0)
    w_mod = nrm((DEPTH, D, N_MOD * D), s * MOD_INIT_SCALE)
    b_mod = nrm((DEPTH, N_MOD * D), 0.01)
    ln_g = 1.0 + nrm((DEPTH, 2, D), 0.02)
    ln_b = nrm((DEPTH, 2, D), 0.02)
    a_w_qkv = jnp.concatenate([nrm((N_EVEN, D, a_qd + a_kd), s), nrm((N_EVEN, D, a_kd), s * DEEPNORM_BETA)], axis=-1)
    a_sink = nrm((N_EVEN, A_HEADS), 0.5)
    a_w_o = nrm((N_EVEN, a_qd, D), a_qd ** -0.5 * DEEPNORM_BETA)
    b_w_qkv = jnp.concatenate([nrm((N_ODD, D, 2 * b_qd), s), nrm((N_ODD, D, b_vd), s * DEEPNORM_BETA)], axis=-1)
    b_lam_q1 = nrm((N_ODD, B_HEAD_DIM), 0.1)
    b_lam_k1 = nrm((N_ODD, B_HEAD_DIM), 0.1)
    b_lam_q2 = nrm((N_ODD, B_HEAD_DIM), 0.1)
    b_lam_k2 = nrm((N_ODD, B_HEAD_DIM), 0.1)
    b_subln_g = 1.0 + nrm((N_ODD, B_V_DIM), 0.02)
    b_w_o = nrm((N_ODD, b_vd, D), b_vd ** -0.5 * DEEPNORM_BETA)
    ff_w_gate = nrm((N_EVEN, D, D_FF), s)
    ff_w_up = nrm((N_EVEN, D, D_FF), s)
    ff_w_down = nrm((N_EVEN, D_FF, D), D_FF ** -0.5 * DEEPNORM_BETA)
    moe_w_router = nrm((N_ODD, D, N_EXPERTS), s)
    moe_w_gate = nrm((N_ODD, N_EXPERTS, D, D_FF_EXPERT), s)
    moe_w_up = nrm((N_ODD, N_EXPERTS, D, D_FF_EXPERT), s)
    moe_w_down = nrm((N_ODD, N_EXPERTS, D_FF_EXPERT, D), D_FF_EXPERT ** -0.5 * DEEPNORM_BETA)
    return {'x': x, 'c': c, 'ctx': ctx, 'c_ctx': c_ctx, 'w_mod': w_mod, 'b_mod': b_mod,
            'ln_g': ln_g, 'ln_b': ln_b, 'a_w_qkv': a_w_qkv, 'a_sink': a_sink, 'a_w_o': a_w_o,
            'b_w_qkv': b_w_qkv, 'b_lam_q1': b_lam_q1, 'b_lam_k1': b_lam_k1, 'b_lam_q2': b_lam_q2,
            'b_lam_k2': b_lam_k2, 'b_subln_g': b_subln_g, 'b_w_o': b_w_o,
            'ff_w_gate': ff_w_gate, 'ff_w_up': ff_w_up, 'ff_w_down': ff_w_down,
            'moe_w_router': moe_w_router, 'moe_w_gate': moe_w_gate, 'moe_w_up': moe_w_up,
            'moe_w_down': moe_w_down}


def reference(x, c, ctx, c_ctx, w_mod, b_mod, ln_g, ln_b, a_w_qkv, a_sink, a_w_o,
              b_w_qkv, b_lam_q1, b_lam_k1, b_lam_q2, b_lam_k2, b_subln_g, b_w_o,
              ff_w_gate, ff_w_up, ff_w_down, moe_w_router, moe_w_gate, moe_w_up, moe_w_down):
    B, L, D = x.shape
    C = ctx.shape[1]
    cos, sin = axial_rope_tables(L, A_HEAD_DIM, x.dtype)
    xl, xc = x, ctx
    for i in range(DEPTH):
        with_ctx = i < DEPTH - 1
        j = i // 2
        sh_a, sc_a, g_a, sh_f, sc_f, g_f = modulation(c, w_mod[i], b_mod[i])
        csh_a, csc_a, cg_a, csh_f, csc_f, cg_f = modulation(c_ctx, w_mod[i], b_mod[i])

        hl = xl * (1.0 + sc_a[:, None]) + sh_a[:, None]
        hc = xc * (1.0 + csc_a) + csh_a
        if i % 2 == 0:
            ol, oc = windowed_gqa(hl, hc, a_w_qkv[j], a_sink[j], a_w_o[j], cos, sin, with_ctx)
        else:
            lam_init = 0.8 - 0.6 * math.exp(-0.3 * i)
            ol, oc = diff_attention(hl, hc, b_w_qkv[j], b_lam_q1[j], b_lam_k1[j], b_lam_q2[j], b_lam_k2[j],
                                    b_subln_g[j], b_w_o[j], cos, sin, lam_init, with_ctx)
        xl = layer_norm(DEEPNORM_ALPHA * xl + (1.0 + g_a[:, None]) * ol, ln_g[i, 0], ln_b[i, 0])
        if with_ctx:
            xc = layer_norm(DEEPNORM_ALPHA * xc + (1.0 + cg_a) * oc, ln_g[i, 0], ln_b[i, 0])

        hl = xl * (1.0 + sc_f[:, None]) + sh_f[:, None]
        if with_ctx:
            hc = xc * (1.0 + csc_f) + csh_f
            h = jnp.concatenate([hc, hl], axis=1)
        else:
            h = hl
        if i % 2 == 0:
            f = swiglu(h, ff_w_gate[j], ff_w_up[j], ff_w_down[j])
        else:
            f = moe_swiglu(h, moe_w_router[j], moe_w_gate[j], moe_w_up[j], moe_w_down[j])
        if with_ctx:
            fc, fl = f[:, :C], f[:, C:]
            xc = layer_norm(DEEPNORM_ALPHA * xc + (1.0 + cg_f) * fc, ln_g[i, 1], ln_b[i, 1])
        else:
            fl = f
        xl = layer_norm(DEEPNORM_ALPHA * xl + (1.0 + g_f[:, None]) * fl, ln_g[i, 1], ln_b[i, 1])
    return xl
```

```cpp
#include <hip/hip_runtime.h>
#include <cstdio>
#include <cstdint>

#ifndef MK_LAUNCH_MODE
#define MK_LAUNCH_MODE 0
#endif

#ifndef PROBE_MASK
#define PROBE_MASK 0
#endif
#ifndef ATT_PROBE
#define ATT_PROBE 0
#endif
#ifndef DIAG_SEL
#define DIAG_SEL 0
#endif
#ifndef DIAG_WAVE
#define DIAG_WAVE 0
#endif
#define LAS __attribute__((address_space(3)))
#define GAS __attribute__((address_space(1)))
typedef unsigned short bf16_t;
typedef short bf16x8 __attribute__((ext_vector_type(8)));
typedef short s16x4 __attribute__((ext_vector_type(4)));
typedef float f32x4 __attribute__((ext_vector_type(4)));
typedef float f32x2 __attribute__((ext_vector_type(2)));
typedef float f32x16 __attribute__((ext_vector_type(16)));
typedef unsigned u32x4 __attribute__((ext_vector_type(4)));
typedef unsigned u32x2 __attribute__((ext_vector_type(2)));

constexpr int D = 1024, NBATCH = 16, SEQ = 2048, CTXL = 256, DEPTH = 4;
constexpr int ML = NBATCH * SEQ;
constexpr int MC = NBATCH * CTXL;
constexpr int MT = ML + MC;
constexpr int DFF = 2816, NEXP = 8, DFE = 3584;
constexpr int NQA = 1536, NQB = 3072;
constexpr int NMOD = 6 * D;
constexpr float LN_EPS = 1e-5f, RMS_EPS = 1e-5f;
constexpr float DN_ALPHA = 1.681792830507429f;
constexpr float QSCALE = 0.125f * 1.4426950408889634f;
constexpr float LOG2E = 1.4426950408889634f;
constexpr int GRID = 256;

constexpr size_t MiB = 1u << 20;
constexpr size_t WS_CTL = 0, CTL_ZERO_BYTES = 1 * MiB;
constexpr size_t WS_MOD = 1 * MiB;
constexpr size_t WS_ROPE = 3 * MiB;
constexpr size_t WS_TOK = 4 * MiB;
constexpr size_t WS_XC = 8 * MiB;
constexpr size_t WS_WAQKV = 24 * MiB;
constexpr size_t WS_WAO = 30 * MiB;
constexpr size_t WS_WBQKV = 34 * MiB;
constexpr size_t WS_WBO = 46 * MiB;
constexpr size_t WS_WFGU = 50 * MiB;
constexpr size_t WS_WFD = 72 * MiB;
constexpr size_t WS_WMGU = 84 * MiB;
constexpr size_t WS_WMD = 308 * MiB;
constexpr size_t WS_H = 420 * MiB;
constexpr size_t WS_BIG = 492 * MiB;
constexpr size_t WS_HID = 568 * MiB;
constexpr size_t WS_PARTS = 834 * MiB;
constexpr size_t WS_XB = 872 * MiB;
constexpr size_t WS_HG1 = 944 * MiB;
constexpr size_t WS_END = 1020 * MiB;
constexpr int NSPLIT_TILE0 = 128, SPLIT_ROW0 = NSPLIT_TILE0 * 256;
constexpr size_t PART_STRIDE = (size_t)6144 * 1024;
static_assert(WS_WFD + (size_t)2 * 1024 * 2816 * 2 <= WS_WMGU, "ws map");
static_assert(WS_WMGU + (size_t)2 * 8 * 7168 * 1024 * 2 <= WS_WMD, "ws map");
static_assert(WS_WMD + (size_t)2 * 8 * 1024 * 3584 * 2 <= WS_H, "ws map");
static_assert(WS_BIG + (size_t)MT * NQB * 2 <= WS_END && WS_HID + (size_t)38912 * DFE * 2 <= WS_END, "ws map");
constexpr int TOK_E = 0, TOK_W = MT, TOK_POS = 3 * MT, TOK_SLOT = 5 * MT;
constexpr int TOK_BLK = 7 * MT;
constexpr int CW_BAR = 4096;
constexpr int CW_CNT = 8192;
constexpr size_t CTL_RIDX = 262144;
constexpr int RIDX_HALF = 38912;

constexpr int RING_BYTES = 131072;
constexpr int LDSCTL_OFF = 143360, MISC_OFF = LDSCTL_OFF + 320;
constexpr int LDS_BYTES = 147456;

#define LDS_WAIT() asm volatile("s_waitcnt lgkmcnt(0)" ::: "memory")
#define VM_WAIT() asm volatile("s_waitcnt vmcnt(0)" ::: "memory")

__device__ __forceinline__ unsigned cvt_pk_bf16(float lo, float hi) { unsigned r; asm volatile("v_cvt_pk_bf16_f32 %0, %1, %2" : "=v"(r) : "v"(lo), "v"(hi)); return r; }
typedef float f32x2_t __attribute__((ext_vector_type(2))); typedef __bf16 bf16x2_t __attribute__((ext_vector_type(2)));
__device__ __forceinline__ unsigned cvtpk_s(float lo, float hi) { f32x2_t v = {lo, hi}; bf16x2_t b = __builtin_convertvector(v, bf16x2_t); return __builtin_bit_cast(unsigned, b); }
__device__ __forceinline__ float bf_lo(unsigned w) { return __uint_as_float(w << 16); }
__device__ __forceinline__ float bf_hi(unsigned w) { return __uint_as_float(w & 0xffff0000u); }
__device__ __forceinline__ int fresh_tid() { int t = threadIdx.x; asm volatile("" : "+v"(t)); return t; }
__device__ __forceinline__ float wave_sum(float v) {
#pragma unroll
    for (int o = 1; o < 64; o <<= 1) v += __shfl_xor(v, o);
    return v;
}

namespace pg8 {
constexpr int BM = 256, BK = 64, HALF = 128, HTB = HALF * BK * 2, STAGE_BYTES = 8 * HTB, NXCD = 8, WGM = 8;
__host__ __device__ __forceinline__ int lds_byte(int r, int c) { const int st = (r >> 4) * 2 + (c >> 5), rr = r & 15, cc = c & 31, ob = rr * 64 + cc * 2; return st * 1024 + (ob ^ (((ob >> 9) & 1) << 5)); }
__host__ __device__ __forceinline__ void stage_rc(int b, int& R, int& C) { const int st = b / 1024, sb = b % 1024, swz = sb ^ (((sb >> 9) & 1) << 5); R = (st >> 1) * 16 + swz / 64; C = (st & 1) * 32 + (swz % 64) / 2; }
__host__ __device__ __forceinline__ int perm32(int rho) { const int n = rho >> 4, i = rho & 15; return 8 * (i >> 2) + 4 * n + (i & 3); }

struct Unit { int pm, pn, pb, kt0, nkt, part; };
struct Gemm { const bf16_t* A; const bf16_t* Bt; int K; unsigned* diag = nullptr; };

struct GroupOrder {
    int nM, nN, nwg, G, c, nMf, nfull, KT;
    int ts1, ts2, ts3, ts4, ts5, ts6, ts7;
    __device__ __forceinline__ void init(int nM_, int nN_, int G_, int c_, int KT_, int nMf_ = 0x7fffffff) {
        nM = nM_; nN = nN_; G = G_; c = c_; KT = KT_; nMf = nMf_ < nM_ ? nMf_ : nM_; nfull = nMf * nN; nwg = nfull + 4 * (nM - nMf) * nN;
        ts1 = ts2 = ts3 = ts4 = ts5 = ts6 = ts7 = 0x7fffffff; }
    __device__ __forceinline__ bool next(int i, Unit& u) const {
        const long L = (long)i * G + c; if (L >= nwg) return false;
        int pm, pn, kt0, nkt, part;
        if (L < nfull) {
            int wgid = (int)L; { const int q = nfull / NXCD, r = nfull % NXCD, xcd = wgid % NXCD, off = wgid / NXCD; wgid = (xcd < r ? xcd * (q + 1) : r * (q + 1) + (xcd - r) * q) + off; }
            const int nig = WGM * nN, gid = wgid / nig, fm = gid * WGM, gsz = (nMf - fm) < WGM ? (nMf - fm) : WGM;
            pm = fm + ((wgid % nig) % gsz); pn = (wgid % nig) / gsz; kt0 = 0; nkt = KT; part = 0;
        } else {
            const int Ls = (int)L - nfull, uu = Ls >> 2; part = Ls & 3;
            pm = nMf + uu / nN; pn = uu % nN;
            const int base = (KT >> 2) & ~1, rem2 = (KT - 4 * base) >> 1;
            nkt = base + (part < rem2 ? 2 : 0); kt0 = part * base + 2 * (part < rem2 ? part : rem2);
        }
        u.pm = pm; u.pn = pn; u.kt0 = kt0; u.nkt = nkt; u.part = part;
        const int e = (pm >= ts1) + (pm >= ts2) + (pm >= ts3) + (pm >= ts4) + (pm >= ts5) + (pm >= ts6) + (pm >= ts7);
        u.pb = e * nN + pn; return true;
    }
};

struct EpiBf16 {
    static constexpr bool PERM = true;
    bf16_t* O0; int ldc; bf16_t* Op; size_t pstride;
    __device__ __forceinline__ void operator()(const f32x4 (&acc)[2][2][4][2], const Unit& u, int wr, int wc, int fr, int fq) const {
        bf16_t* O = u.part == 0 ? O0 : Op + (size_t)(u.part - 1) * pstride;
        const int row0 = u.pm * BM + wr * 64 + fr, col0 = u.pn * BM + wc * 32 + 8 * fq;
#pragma unroll
        for (int ai = 0; ai < 2; ++ai)
#pragma unroll
            for (int m = 0; m < 4; ++m) { bf16_t* rowp = O + (size_t)(row0 + ai * HALF + m * 16) * ldc + col0;
#pragma unroll
                for (int bj = 0; bj < 2; ++bj) { const f32x4 v0 = acc[ai][bj][m][0], v1 = acc[ai][bj][m][1];
                    u32x4 w; w.x = cvtpk_s(v0[0], v0[1]); w.y = cvtpk_s(v0[2], v0[3]); w.z = cvtpk_s(v1[0], v1[1]); w.w = cvtpk_s(v1[2], v1[3]);
                    *(u32x4*)(rowp + bj * HALF) = w; } }
    }
};
struct EpiSwiglu {
    static constexpr bool PERM = true;
    bf16_t* O; int ldc;
    __device__ __forceinline__ void operator()(const f32x4 (&acc)[2][2][4][2], const Unit& u, int wr, int wc, int fr, int fq) const {
        const int row0 = u.pm * BM + wr * 64 + fr, col0 = u.pn * HALF + wc * 32 + 8 * fq;
#pragma unroll
        for (int ai = 0; ai < 2; ++ai)
#pragma unroll
            for (int m = 0; m < 4; ++m) { bf16_t* rowp = O + (size_t)(row0 + ai * HALF + m * 16) * ldc + col0;
                float h[8];
#pragma unroll
                for (int n = 0; n < 2; ++n)
#pragma unroll
                    for (int e = 0; e < 4; ++e) { const float g = acc[ai][0][m][n][e], up = acc[ai][1][m][n][e];
                        h[n * 4 + e] = g * __builtin_amdgcn_rcpf(1.0f + __builtin_amdgcn_exp2f(-LOG2E * g)) * up; }
                u32x4 w; w.x = cvt_pk_bf16(h[0], h[1]); w.y = cvt_pk_bf16(h[2], h[3]); w.z = cvt_pk_bf16(h[4], h[5]); w.w = cvt_pk_bf16(h[6], h[7]);
                *(u32x4*)rowp = w; }
    }
};
struct EpiQKV {
    static constexpr bool PERM = false;
    bf16_t* O; int ldc; int n_rope_tiles, n_q_tiles, n_lat_tiles; const LAS float* cosT; const LAS float* sinT;
    __device__ __forceinline__ void operator()(const f32x4 (&acc)[2][2][4][2], const Unit& u, int wr, int wc, int fr, int fq) const {
        const int row0 = u.pm * BM + wr * 64 + fr, col0 = u.pn * BM + wc * 32 + 4 * fq;
        const bool rope = (u.pn < n_rope_tiles) && (u.pm < n_lat_tiles);
        const float sc = (u.pn < n_q_tiles) ? QSCALE : 1.0f;
#pragma unroll
        for (int ai = 0; ai < 2; ++ai)
#pragma unroll
            for (int m = 0; m < 4; ++m) { const int row = row0 + ai * HALF + m * 16; bf16_t* rowp = O + (size_t)row * ldc + col0;
                f32x4 cs = (f32x4){1.f, 1.f, 1.f, 1.f}, sn = (f32x4){0.f, 0.f, 0.f, 0.f};
                if (rope) { const int t = row & (SEQ - 1); const int pos = (wc & 1) ? (t & 63) : (t >> 6);
                    cs = *(const LAS f32x4*)(cosT + pos * 16 + 4 * fq); sn = *(const LAS f32x4*)(sinT + pos * 16 + 4 * fq); }
#pragma unroll
                for (int bj = 0; bj < 2; ++bj) { const f32x4 x1 = acc[ai][bj][m][0], x2 = acc[ai][bj][m][1];
                    const f32x4 o1 = (x1 * cs - x2 * sn) * sc, o2 = (x2 * cs + x1 * sn) * sc;
                    u32x2 w1, w2; w1.x = cvt_pk_bf16(o1[0], o1[1]); w1.y = cvt_pk_bf16(o1[2], o1[3]); w2.x = cvt_pk_bf16(o2[0], o2[1]); w2.y = cvt_pk_bf16(o2[2], o2[3]);
                    *(u32x2*)(rowp + bj * HALF) = w1; *(u32x2*)(rowp + bj * HALF + 16) = w2; } }
    }
};

constexpr int GATHER_MAX_UNITS = 17;
template <class Epi, class Sched, bool GATHER = false>
__device__ __forceinline__ void gemm_phase(LAS unsigned char* lds, const Gemm g, const Sched& S, const Epi& E, const unsigned short* ridx = nullptr) {
    const int tid = fresh_tid(), wid = __builtin_amdgcn_readfirstlane(tid >> 6), lane = tid & 63, wr = wid >> 2, wc = wid & 3, fr = lane & 15, fq = lane >> 4;
    const int K = g.K;
    unsigned voffA[2], voffB[2];
#pragma unroll
    for (int i = 0; i < 2; ++i) { int R, C; stage_rc(tid * 16 + i * 8192, R, C); const int Rb = Epi::PERM ? ((R & ~31) + perm32(R & 31)) : R;
        voffA[i] = (unsigned)(R * K + C) * 2u; voffB[i] = (unsigned)(Rb * K + C) * 2u; }
    const size_t kstep = (size_t)(BK * 2);
    const size_t hstep = (size_t)HALF * K * 2;
    const size_t tstep = 2 * hstep;
    const unsigned ldsw = (unsigned)wid * 1024u;
    const int aoff = lds_byte(wr * 64 + fr, fq * 8), boff = lds_byte(wc * 32 + fr, fq * 8);
#define PG8_SA(b, h) (((b) * 2 + (h)) * HTB)
#define PG8_SB(b, h) ((4 + (b) * 2 + (h)) * HTB)
#define PG8_STAGE(bufoff, gbase, voff) do { _Pragma("unroll") for (int _i = 0; _i < 2; ++_i) \
        __builtin_amdgcn_global_load_lds((const unsigned*)((const char*)(gbase) + (voff)[_i]), (LAS unsigned*)(lds + (bufoff) + ldsw + _i * 8192), 16, 0, 0); } while (0)
#define PG8_LDA(dst, b, h) do { _Pragma("unroll") for (int m = 0; m < 4; ++m) _Pragma("unroll") for (int k = 0; k < 2; ++k) dst[m][k] = *(const LAS bf16x8*)(lds + PG8_SA(b, h) + aoff + m * 2048 + k * 1024); } while (0)
#define PG8_LDB(dst, b, h) do { _Pragma("unroll") for (int n = 0; n < 2; ++n) _Pragma("unroll") for (int k = 0; k < 2; ++k) dst[n][k] = *(const LAS bf16x8*)(lds + PG8_SB(b, h) + boff + n * 2048 + k * 1024); } while (0)
#define PG8_MMA(ai, bj, At, Bt) do { __builtin_amdgcn_s_setprio(1); _Pragma("unroll") for (int m = 0; m < 4; ++m) _Pragma("unroll") for (int n = 0; n < 2; ++n) _Pragma("unroll") for (int k = 0; k < 2; ++k) \
        acc[ai][bj][m][n] = __builtin_amdgcn_mfma_f32_16x16x32_bf16(Bt[n][k], At[m][k], acc[ai][bj][m][n], 0, 0, 0); __builtin_amdgcn_s_setprio(0); } while (0)
#define PG8_WAIT_V(n) asm volatile("s_waitcnt vmcnt(" #n ")" ::: "memory")
#define PG8_WAIT_L(n) asm volatile("s_waitcnt lgkmcnt(" #n ")" ::: "memory")
#define PG8_BAR __builtin_amdgcn_s_barrier()
#define PG8_SCHED __builtin_amdgcn_sched_barrier(0)
    Unit cur, nxt; int ui = 0;
    if (!S.next(0, cur)) return;
    unsigned cv[2][2], nv[2][2];
    LAS unsigned short* gtab = (LAS unsigned short*)(lds + STAGE_BYTES);
    int gR[2], gC2[2];
    if constexpr (GATHER) {
#pragma unroll
        for (int i = 0; i < 2; ++i) { int R, C; stage_rc(tid * 16 + i * 8192, R, C); gR[i] = R; gC2[i] = C * 2; }
        { Unit u; for (int i = 0; i < GATHER_MAX_UNITS && S.next(i, u); ++i) if (tid < 256) gtab[i * 256 + tid] = ridx[u.pm * 256 + tid]; }
        __syncthreads();
#pragma unroll
        for (int h = 0; h < 2; ++h)
#pragma unroll
            for (int i = 0; i < 2; ++i) cv[h][i] = (unsigned)gtab[h * 128 + gR[i]] * (unsigned)(K * 2) + (unsigned)gC2[i];
    }
    const bool gdg = DIAG_SEL && g.diag != nullptr && wid == DIAG_WAVE;
    unsigned long long g0 = 0, gep = 0, gc0 = 0;
    if (gdg) { g0 = __builtin_amdgcn_s_memrealtime(); gc0 = __builtin_amdgcn_s_memtime(); }
    f32x4 acc[2][2][4][2];
#pragma unroll
    for (int a = 0; a < 2; ++a)
#pragma unroll
        for (int b = 0; b < 2; ++b)
#pragma unroll
            for (int m = 0; m < 4; ++m)
#pragma unroll
                for (int n = 0; n < 2; ++n) acc[a][b][m][n] = (f32x4){0.f, 0.f, 0.f, 0.f};
    bf16x8 At[4][2], B0[2][2], B1[2][2];
#define PG8_STAGE_A(bufoff, p, h) do { if constexpr (GATHER) { PG8_STAGE(bufoff, p, cv[h]); } else { PG8_STAGE(bufoff, (p) + (h) * hstep, voffA); } } while (0)
    const char* cA = (const char*)g.A + (GATHER ? (size_t)0 : (size_t)cur.pm * tstep) + (size_t)cur.kt0 * kstep; const char* cB = (const char*)g.Bt + (size_t)cur.pb * tstep + (size_t)cur.kt0 * kstep;
    PG8_STAGE(PG8_SB(0, 0), cB, voffB); PG8_STAGE(PG8_SB(0, 1), cB + hstep, voffB); PG8_STAGE_A(PG8_SA(0, 0), cA, 0); PG8_STAGE_A(PG8_SA(0, 1), cA, 1);
    if (wr == 1) PG8_BAR;
    PG8_WAIT_V(2); PG8_BAR;
    PG8_STAGE(PG8_SB(1, 0), cB + kstep, voffB); PG8_STAGE_A(PG8_SA(1, 0), cA + kstep, 0); PG8_STAGE(PG8_SB(1, 1), cB + hstep + kstep, voffB);
    PG8_WAIT_V(6); PG8_BAR;
    for (;;) {
        const bool has_next = S.next(ui + 1, nxt);
        const char* nA = has_next ? (const char*)g.A + (GATHER ? (size_t)0 : (size_t)nxt.pm * tstep) + (size_t)nxt.kt0 * kstep : cA; const char* nB = has_next ? (const char*)g.Bt + (size_t)nxt.pb * tstep + (size_t)nxt.kt0 * kstep : cB;
        if constexpr (GATHER) {
#pragma unroll
            for (int h = 0; h < 2; ++h)
#pragma unroll
                for (int i = 0; i < 2; ++i) nv[h][i] = has_next ? (unsigned)gtab[(ui + 1) * 256 + h * 128 + gR[i]] * (unsigned)(K * 2) + (unsigned)gC2[i] : cv[h][i];
        }
        const int nt = cur.nkt;
        for (int t = 0; t < nt; t += 2) {
            const bool last = (t == nt - 2);
            const char* a1 = cA + (size_t)(t + 1) * kstep;
            const char* a2 = last ? nA : cA + (size_t)(t + 2) * kstep; const char* b2 = last ? nB : cB + (size_t)(t + 2) * kstep;
            const char* a3 = a2 + kstep; const char* b3 = b2 + kstep;
            PG8_LDB(B0, 0, 0); PG8_LDB(B1, 0, 1); PG8_SCHED; PG8_LDA(At, 0, 0); PG8_STAGE_A(PG8_SA(1, 1), a1, 1);
            if constexpr (GATHER) { if (last) {
#pragma unroll
                for (int h = 0; h < 2; ++h)
#pragma unroll
                    for (int i = 0; i < 2; ++i) cv[h][i] = nv[h][i]; } }
            PG8_WAIT_V(8); PG8_WAIT_L(0); PG8_BAR; PG8_MMA(0, 0, At, B0); PG8_MMA(0, 1, At, B1); PG8_BAR; PG8_SCHED;
            PG8_LDA(At, 0, 1); PG8_STAGE(PG8_SB(0, 0), b2, voffB); PG8_STAGE(PG8_SB(0, 1), b2 + hstep, voffB); PG8_STAGE_A(PG8_SA(0, 0), a2, 0);
            PG8_WAIT_V(8); PG8_WAIT_L(0); PG8_BAR; PG8_MMA(1, 0, At, B0); PG8_MMA(1, 1, At, B1); PG8_BAR; PG8_SCHED;
            PG8_LDB(B0, 1, 0); PG8_LDB(B1, 1, 1); PG8_SCHED; PG8_LDA(At, 1, 0); PG8_STAGE_A(PG8_SA(0, 1), a2, 1);
            PG8_WAIT_V(8); PG8_WAIT_L(0); PG8_BAR; PG8_MMA(0, 0, At, B0); PG8_MMA(0, 1, At, B1); PG8_BAR; PG8_SCHED;
            PG8_LDA(At, 1, 1); PG8_STAGE(PG8_SB(1, 0), b3, voffB); PG8_STAGE(PG8_SB(1, 1), b3 + hstep, voffB); PG8_STAGE_A(PG8_SA(1, 0), a3, 0);
            PG8_WAIT_V(8); PG8_WAIT_L(0); PG8_BAR; PG8_MMA(1, 0, At, B0); PG8_MMA(1, 1, At, B1); PG8_BAR; PG8_SCHED;
        }
        if (wr == 0) PG8_BAR;
        unsigned long long ge0 = 0; if (gdg) ge0 = __builtin_amdgcn_s_memrealtime();
        E(acc, cur, wr, wc, fr, fq);
        if (gdg) { asm volatile("" ::: "memory"); gep += __builtin_amdgcn_s_memrealtime() - ge0; }
        if (!has_next) break;
#pragma unroll
        for (int a = 0; a < 2; ++a)
#pragma unroll
            for (int b = 0; b < 2; ++b)
#pragma unroll
                for (int m = 0; m < 4; ++m)
#pragma unroll
                    for (int n = 0; n < 2; ++n) acc[a][b][m][n] = (f32x4){0.f, 0.f, 0.f, 0.f};
        cur = nxt; cA = nA; cB = nB; ++ui;
        if (wr == 1) PG8_BAR;
    }
    PG8_WAIT_V(0);
    PG8_BAR;
    if (gdg && lane == 0) { const unsigned long long g1 = __builtin_amdgcn_s_memrealtime(), gc1 = __builtin_amdgcn_s_memtime(); g.diag[8] = (unsigned)(g1 - g0); g.diag[9] = (unsigned)gep; g.diag[10] = (unsigned)((gc1 - gc0) >> 8); g.diag[11] = (unsigned)(ui + 1) * 500u; }
#undef PG8_SA
#undef PG8_SB
#undef PG8_STAGE
#undef PG8_STAGE_A
#undef PG8_LDA
#undef PG8_LDB
#undef PG8_MMA
#undef PG8_WAIT_V
#undef PG8_WAIT_L
#undef PG8_BAR
#undef PG8_SCHED
}
}

namespace att {
typedef LAS const char* lcptr;
typedef short v4i16_t __attribute__((ext_vector_type(4)));
constexpr int KBUF = 0, KS = 16384, NKS = 4, VBUF = 65536, VS = 16384, NVS = 3, WSF = 114688, XCH = 32768;
constexpr float THR = 8.0f;
__device__ __forceinline__ int crow(int r, int hi) { return (r & 3) + 8 * (r >> 2) + 4 * hi; }
__device__ __forceinline__ s16x4 vtr(lcptr p) { return __builtin_bit_cast(s16x4, __builtin_amdgcn_ds_read_tr16_b64_v4i16((LAS v4i16_t*)p)); }

struct UnitD {
    int qrow0;
    int qcol, kcol, vcol;
    int n1, base1, n2, base2;
    int kp0;
    int qp0;
    int masked;
    float sink2;
    int use_sink;
    int ocol;
    unsigned* diag;
};

__device__ __forceinline__ void glds16(const void* gsrc, unsigned lds_dst) { unsigned keep;
    asm volatile("s_mov_b32 %0, m0\n\ts_mov_b32 m0, %2\n\ts_nop 0\n\tglobal_load_lds_dwordx4 %1, off\n\ts_mov_b32 m0, %0" : "=&s"(keep) : "v"(gsrc), "s"(lds_dst) : "memory"); }
template <bool TB>
__device__ __forceinline__ void dma_k(const bf16_t* QKV, int NQ, int rowbase, int kcol, unsigned kbuf, int wid, int lane) {
#pragma unroll
    for (int i = 0; i < (TB ? 2 : 1); ++i) { const int pc = wid + 8 * i, head = pc >> 3, ch = pc & 7;
        const bf16_t* src = QKV + (size_t)(rowbase + lane) * NQ + kcol + head * 64 + ch * 8;
        glds16(src, (unsigned)__builtin_amdgcn_readfirstlane(kbuf + head * 8192 + ch * 1024)); }
}
template <bool TB>
__device__ __forceinline__ void dma_v(const bf16_t* QKV, int NQ, int rowbase, int vcol, unsigned vbuf, int wid, int lane) {
#pragma unroll
    for (int i = 0; i < (TB ? 2 : 1); ++i) { const int pv = wid + 8 * i, dblk = pv >> 2, rg = pv & 3;
        const bf16_t* src = QKV + (size_t)(rowbase + 16 * rg + (lane >> 2)) * NQ + vcol + dblk * 32 + (lane & 3) * 8;
        glds16(src, (unsigned)__builtin_amdgcn_readfirstlane(vbuf + pv * 1024)); }
}

template <bool TB>
__device__ __forceinline__ void attn_unit(LAS unsigned char* lds, const bf16_t* QKV, int NQ, bf16_t* O, const UnitD& U, float lam, float post_scale, const float* subln) {
    constexpr int NDB = TB ? 4 : 2;
    const int tid = fresh_tid(), lane = tid & 63, r32 = lane & 31, hi = lane >> 5; const int wid = __builtin_amdgcn_readfirstlane(tid >> 6);
    const int sub = wid >> 2, w4 = wid & 3;
    LAS float* wsf = (LAS float*)(lds + WSF) + wid * 64;
    const int NT = U.n1 + U.n2;
#define ATT_ROWBASE(tt) ((tt) < U.n1 ? U.base1 + 64 * (tt) : U.base2 + 64 * ((tt) - U.n1))
    const unsigned lds0 = (unsigned)(uintptr_t)lds;
    const bool dg = false;
    unsigned long long dt0 = 0, dt1 = 0, dt2 = 0, dwait = 0, dA = 0, dB = 0, dsa = 0;
    if (dg) dt0 = __builtin_amdgcn_s_memrealtime();
    dma_k<TB>(QKV, NQ, U.base1, U.kcol, lds0 + KBUF, wid, lane);
    dma_v<TB>(QKV, NQ, U.base1, U.vcol, lds0 + VBUF, wid, lane);
    if (NT > 1) { dma_k<TB>(QKV, NQ, ATT_ROWBASE(1), U.kcol, lds0 + KBUF + KS, wid, lane); dma_v<TB>(QKV, NQ, ATT_ROWBASE(1), U.vcol, lds0 + VBUF + VS, wid, lane); }
    if (NT > 2) dma_k<TB>(QKV, NQ, ATT_ROWBASE(2), U.kcol, lds0 + KBUF + 2 * KS, wid, lane);
    bf16x8 qr[4];
    { const bf16_t* qp = QKV + (size_t)(U.qrow0 + w4 * 32 + r32) * NQ + U.qcol + hi * 8;
#pragma unroll
      for (int d0 = 0; d0 < 4; ++d0) qr[d0] = *(const bf16x8*)(qp + d0 * 16); }
    f32x16 o[NDB];
#pragma unroll
    for (int d = 0; d < NDB; ++d) o[d] = f32x16{};
    f32x16 negm = f32x16{}; float mhat = 0.f, l_reg = 0.f;
    const int qpos = U.qp0 + r32;
    VM_WAIT(); __builtin_amdgcn_s_barrier(); asm volatile("" ::: "memory");
    asm volatile("" : "+v"(qr[0]), "+v"(qr[1]), "+v"(qr[2]), "+v"(qr[3]));
    int ks = 0, vs = 0;
#define ATT_SBAR() __builtin_amdgcn_sched_barrier(0)
#define ATT_KLOAD(slot) do { const lcptr kb_ = (lcptr)(lds + KBUF + (slot) * KS + (TB ? sub * 8192 : 0)) + hi * 1024 + r32 * 16; \
        _Pragma("unroll") for (int i_ = 0; i_ < 8; ++i_) kf[i_] = *(const LAS bf16x8*)(kb_ + (i_ >> 1) * 2048 + (i_ & 1) * 512); } while (0)
#define ATT_VLOAD(LO, HI, d) do { _Pragma("unroll") for (int k4 = 0; k4 < 4; ++k4) { LO[k4] = vtr(vp + (d) * 4096 + k4 * 1024); HI[k4] = vtr(vp + (d) * 4096 + k4 * 1024 + 512); } } while (0)
#define ATT_VMMA(LO, HI, d) do { _Pragma("unroll") for (int k4 = 0; k4 < 4; ++k4) o[d] = __builtin_amdgcn_mfma_f32_32x32x16_bf16(__builtin_bit_cast(bf16x8, pw[k4]), \
        ((bf16x8){LO[k4][0], LO[k4][1], LO[k4][2], LO[k4][3], HI[k4][0], HI[k4][1], HI[k4][2], HI[k4][3]}), o[d], 0, 0, 0); } while (0)
    bf16x8 kf[8];
    f32x16 p0, p1; u32x4 pw[4];
#define ATT_QK() do { p0 = __builtin_amdgcn_mfma_f32_32x32x16_bf16(kf[0], qr[0], negm, 0, 0, 0); p1 = __builtin_amdgcn_mfma_f32_32x32x16_bf16(kf[1], qr[0], negm, 0, 0, 0); \
        _Pragma("unroll") for (int d0 = 1; d0 < 4; ++d0) { p0 = __builtin_amdgcn_mfma_f32_32x32x16_bf16(kf[2 * d0], qr[d0], p0, 0, 0, 0); p1 = __builtin_amdgcn_mfma_f32_32x32x16_bf16(kf[2 * d0 + 1], qr[d0], p1, 0, 0, 0); } } while (0)
#define ATT_SOFTMAX(tt) do { \
        if (!TB) { if (U.masked && (tt) >= U.n1) { const int dl0 = U.kp0 + 64 * ((tt) - U.n1) + 4 * hi - qpos; \
            _Pragma("unroll") for (int r = 0; r < 16; ++r) { const int dlt = dl0 + (r & 3) + 8 * (r >> 2); \
                if (dlt > 128 || dlt < -128) p0[r] = -1e30f; if (dlt + 32 > 128 || dlt + 32 < -128) p1[r] = -1e30f; } } } \
        float rm; { float a = __builtin_fmaxf(__builtin_fmaxf(p0[0], p0[1]), p1[0]), b = __builtin_fmaxf(__builtin_fmaxf(p0[2], p0[3]), p1[1]); a = __builtin_fmaxf(__builtin_fmaxf(a, p1[2]), p1[3]); \
          _Pragma("unroll") for (int r = 4; r < 16; r += 4) { a = __builtin_fmaxf(__builtin_fmaxf(a, p0[r]), p0[r + 1]); b = __builtin_fmaxf(__builtin_fmaxf(b, p0[r + 2]), p0[r + 3]); a = __builtin_fmaxf(__builtin_fmaxf(a, p1[r]), p1[r + 1]); b = __builtin_fmaxf(__builtin_fmaxf(b, p1[r + 2]), p1[r + 3]); } \
          rm = __builtin_fmaxf(a, b); auto rr = __builtin_amdgcn_permlane32_swap(__float_as_uint(rm), __float_as_uint(rm), false, false); rm = __builtin_fmaxf(__uint_as_float(rr[0]), __uint_as_float(rr[1])); } \
        if ((tt) == 0) { mhat = rm; _Pragma("unroll") for (int r = 0; r < 16; ++r) { p0[r] -= rm; p1[r] -= rm; negm[r] = -mhat; } } \
        else if (__any(rm > THR)) { const float dl = __builtin_fmaxf(rm, 0.f); mhat += dl; \
            _Pragma("unroll") for (int r = 0; r < 16; ++r) { p0[r] -= dl; p1[r] -= dl; negm[r] = -mhat; } \
            const float f = __builtin_amdgcn_exp2f(-dl); l_reg *= f; if (hi == 0) wsf[r32] = f; LDS_WAIT(); \
            _Pragma("unroll") for (int r = 0; r < 16; ++r) { const float fr_ = wsf[crow(r, hi)]; _Pragma("unroll") for (int d = 0; d < NDB; ++d) o[d][r] *= fr_; } } \
        float sacc = 0.f; \
        _Pragma("unroll") for (int r = 0; r < 16; ++r) { p0[r] = __builtin_amdgcn_exp2f(p0[r]); p1[r] = __builtin_amdgcn_exp2f(p1[r]); sacc += p0[r] + p1[r]; } \
        l_reg += sacc; \
        _Pragma("unroll") for (int s = 0; s < 2; ++s) { pw[s] = (u32x4){cvt_pk_bf16(p0[8 * s], p0[8 * s + 1]), cvt_pk_bf16(p0[8 * s + 2], p0[8 * s + 3]), cvt_pk_bf16(p0[8 * s + 4], p0[8 * s + 5]), cvt_pk_bf16(p0[8 * s + 6], p0[8 * s + 7])}; \
            pw[2 + s] = (u32x4){cvt_pk_bf16(p1[8 * s], p1[8 * s + 1]), cvt_pk_bf16(p1[8 * s + 2], p1[8 * s + 3]), cvt_pk_bf16(p1[8 * s + 4], p1[8 * s + 5]), cvt_pk_bf16(p1[8 * s + 6], p1[8 * s + 7])}; } } while (0)
    ATT_KLOAD(0);
    ATT_QK();
    ATT_SOFTMAX(0);
    if (sub == 1) __builtin_amdgcn_s_setprio(1);
    for (int t = 0; t < NT; ++t) {
        if (t + 2 < NT) { if (TB) asm volatile("s_waitcnt vmcnt(4)" ::: "memory"); else asm volatile("s_waitcnt vmcnt(2)" ::: "memory"); } else VM_WAIT();
        __builtin_amdgcn_s_barrier(); asm volatile("" ::: "memory");
        if (t + 3 < NT) { const int k3 = (ks + 3) & 3; dma_k<TB>(QKV, NQ, ATT_ROWBASE(t + 3), U.kcol, lds0 + KBUF + k3 * KS, wid, lane); }
        if (t + 2 < NT) { int v2 = vs + 2; v2 = v2 >= 3 ? v2 - 3 : v2; dma_v<TB>(QKV, NQ, ATT_ROWBASE(t + 2), U.vcol, lds0 + VBUF + v2 * VS, wid, lane); }
        const lcptr vp = (lcptr)(lds + VBUF + vs * VS) + ((lane >> 4) & 1) * 32 + (lane & 3) * 8 + (4 * hi + ((lane & 15) >> 2)) * 64;
        s16x4 va_lo[4], va_hi[4], vb_lo[4], vb_hi[4];
        const bool more = t + 1 < NT;
        ATT_SBAR();
        ATT_VLOAD(va_lo, va_hi, 0);
        ATT_VLOAD(vb_lo, vb_hi, 1);
        ATT_SBAR();
        ATT_VMMA(va_lo, va_hi, 0);
        if (TB) { ATT_SBAR(); ATT_VLOAD(va_lo, va_hi, NDB - 2); }
        else { ATT_SBAR(); if (more) { const int k1 = (ks + 1) & 3; ATT_KLOAD(k1); } }
        ATT_SBAR();
        ATT_VMMA(vb_lo, vb_hi, 1);
        if (TB) { ATT_SBAR(); ATT_VLOAD(vb_lo, vb_hi, NDB - 1); ATT_SBAR(); ATT_VMMA(va_lo, va_hi, NDB - 2); ATT_SBAR(); if (more) { const int k1 = (ks + 1) & 3; ATT_KLOAD(k1); } ATT_SBAR(); ATT_VMMA(vb_lo, vb_hi, NDB - 1); }
        ATT_SBAR();
        if (more) {
            ATT_QK();
            ATT_SBAR();
            ATT_SOFTMAX(t + 1);
        }
        ks = (ks + 1) & 3; vs = vs == 2 ? 0 : vs + 1;
    }
    __builtin_amdgcn_s_setprio(0);
#undef ATT_QK
#undef ATT_SOFTMAX
#undef ATT_SBAR
#undef ATT_KLOAD
#undef ATT_VLOAD
#undef ATT_VMMA
#undef ATT_SEAM
#undef ATT_ROWBASE
    { auto rr = __builtin_amdgcn_permlane32_swap(__float_as_uint(l_reg), __float_as_uint(l_reg), false, false); l_reg = __uint_as_float(rr[0]) + __uint_as_float(rr[1]); }
    if (!TB) { if (U.use_sink) l_reg += __builtin_amdgcn_exp2f(U.sink2 - mhat); }
    if (hi == 0) wsf[32 + r32] = l_reg;
    LDS_WAIT();
    float rli[16];
#pragma unroll
    for (int r = 0; r < 16; ++r) rli[r] = 1.0f / wsf[32 + crow(r, hi)];
    const int orow0 = U.qrow0 + w4 * 32;
    if (!TB) {
        __builtin_amdgcn_s_barrier(); asm volatile("" ::: "memory");
        LAS unsigned short* stg = (LAS unsigned short*)(lds + (sub == 0 ? KBUF + 3 * KS : VBUF + 2 * VS)) + w4 * 2048;
#pragma unroll
        for (int r = 0; r < 16; ++r) {
#pragma unroll
            for (int d = 0; d < NDB; ++d) stg[crow(r, hi) * 64 + d * 32 + r32] = (unsigned short)(cvt_pk_bf16(o[d][r] * rli[r], 0.f) & 0xffffu); }
        LDS_WAIT();
#pragma unroll
        for (int i = 0; i < 4; ++i) { const int row = i * 8 + (lane >> 3), ch = lane & 7; const u32x4 v = *(const LAS u32x4*)(stg + row * 64 + ch * 8);
            *(u32x4*)(O + (size_t)(orow0 + row) * D + U.ocol + ch * 8) = v; }
    } else {
        LAS float* X = (LAS float*)(lds + XCH) + (size_t)w4 * 2048 + lane;
#pragma unroll
        for (int rd = 0; rd < 2; ++rd) {
            if (sub == 1) {
#pragma unroll
                for (int d = 0; d < 2; ++d)
#pragma unroll
                    for (int r = 0; r < 16; ++r) X[(d * 16 + r) * 64] = o[2 * rd + d][r] * rli[r];
            }
            LDS_WAIT(); __builtin_amdgcn_s_barrier(); asm volatile("" ::: "memory");
            if (sub == 0) {
#pragma unroll
                for (int d = 0; d < 2; ++d)
#pragma unroll
                    for (int r = 0; r < 16; ++r) o[2 * rd + d][r] = o[2 * rd + d][r] * rli[r] - lam * X[(d * 16 + r) * 64];
            }
            LDS_WAIT(); __builtin_amdgcn_s_barrier(); asm volatile("" ::: "memory");
        }
        if (sub == 0) {
            float gam[NDB];
#pragma unroll
            for (int d = 0; d < NDB; ++d) gam[d] = subln[d * 32 + r32] * post_scale;
#pragma unroll
            for (int r = 0; r < 16; ++r) { float ss = 0.f;
#pragma unroll
                for (int d = 0; d < NDB; ++d) ss += o[d][r] * o[d][r];
#pragma unroll
                for (int off = 1; off < 32; off <<= 1) ss += __shfl_xor(ss, off);
                const float rs = 1.0f / sqrtf(ss * (1.0f / 128.0f) + RMS_EPS);
#pragma unroll
                for (int d = 0; d < NDB; ++d) o[d][r] *= rs * gam[d]; }
            LAS unsigned short* stg = (LAS unsigned short*)(lds + VBUF + 2 * VS) + w4 * 2048;
#pragma unroll
            for (int hf = 0; hf < 2; ++hf) {
#pragma unroll
                for (int r = 0; r < 16; ++r) {
#pragma unroll
                    for (int d = 0; d < 2; ++d) stg[crow(r, hi) * 64 + d * 32 + r32] = (unsigned short)(cvt_pk_bf16(o[2 * hf + d][r], 0.f) & 0xffffu); }
                LDS_WAIT();
#pragma unroll
                for (int i = 0; i < 4; ++i) { const int row = i * 8 + (lane >> 3), ch = lane & 7; const u32x4 v = *(const LAS u32x4*)(stg + row * 64 + ch * 8);
                    *(u32x4*)(O + (size_t)(orow0 + row) * D + U.ocol + hf * 64 + ch * 8) = v; }
                LDS_WAIT();
            }
        }
    }
}
}

#define XB_TMO      128
#define XB_XCNT(j)  (256  + 64 * (j))
#define XB_XSUB(j)  (1280 + 64 * (j))
#define XB_XGEN(j)  (2304 + 64 * (j))
#define XB_TOP      3328
#define XB_TOPGEN   3392
#define XCD_BAR_WORDS 3456
#define XB_SPIN_CAP (1u << 18)

__device__ __forceinline__ unsigned xb_ld(unsigned* p)              { return __hip_atomic_load(p, __ATOMIC_RELAXED, __HIP_MEMORY_SCOPE_AGENT); }
__device__ __forceinline__ unsigned xb_add(unsigned* p, unsigned v) { return __hip_atomic_fetch_add(p, v, __ATOMIC_RELAXED, __HIP_MEMORY_SCOPE_AGENT); }
__device__ __forceinline__ unsigned xb_xcc_id() { return (unsigned)__builtin_amdgcn_s_getreg((3 << 11) | 20) & 0xFu; }
#define XB_SPIN(cond, bar) do { unsigned _sp = 0; while (cond) { __builtin_amdgcn_s_sleep(1); \
    if ((++_sp & 255u) == 0u) { if (xb_ld(&(bar)[XB_TMO])) break; if (_sp > XB_SPIN_CAP) { atomicAdd(&(bar)[XB_TMO], 1u); break; } } } } while (0)

struct XcdBarrier { unsigned* bar; unsigned x; volatile LAS unsigned* st; };

__device__ __forceinline__ XcdBarrier xcd_barrier_post(unsigned* bar, volatile LAS unsigned* st) {
    XcdBarrier b; b.bar = bar; b.x = xb_xcc_id(); b.st = st;
    if (threadIdx.x == 0) (void)xb_add(&bar[XB_XCNT(b.x)], 1u);
    return b;
}
__device__ __forceinline__ void xcd_barrier_complete(unsigned* bar, unsigned x, unsigned& nloc, unsigned& nx) {
    const unsigned G = gridDim.x * gridDim.y * gridDim.z;
    unsigned sum, cnt, mine, sp = 0u;
    for (;;) {
        sum = 0u; cnt = 0u; mine = 0u;
#pragma unroll
        for (unsigned j = 0; j < 16; ++j) { const unsigned c = xb_ld(&bar[XB_XCNT(j)]); sum += c; cnt += (c > 0u) ? 1u : 0u; mine = (j == x) ? c : mine; }
        if (sum == G) break;
        __builtin_amdgcn_s_sleep(1);
        if ((++sp & 255u) == 0u) { if (xb_ld(&bar[XB_TMO])) break; if (sp > XB_SPIN_CAP) { atomicAdd(&bar[XB_TMO], 1u); break; } }
    }
    nloc = mine > 0u ? mine : 1u; nx = cnt > 0u ? cnt : 1u;
}
__device__ __forceinline__ void xcd_barrier(const XcdBarrier& b) {
    asm volatile("s_waitcnt vmcnt(0)" ::: "memory");
    __syncthreads();
    if (threadIdx.x == 0) {
        unsigned* bar = b.bar;
        __builtin_amdgcn_s_waitcnt(0);
        unsigned nloc = b.st[0], nx = b.st[1];
        if (nloc == 0u) { xcd_barrier_complete(bar, b.x, nloc, nx); b.st[0] = nloc; b.st[1] = nx; }
        const unsigned old = xb_add(&bar[XB_XSUB(b.x)], 1u);
        const unsigned gen = old / nloc;
        if (old + 1u == (gen + 1u) * nloc) {
            __builtin_amdgcn_fence(__ATOMIC_RELEASE, "agent");
            asm volatile("s_waitcnt vmcnt(0)" ::: "memory");
            const unsigned og = xb_add(&bar[XB_TOP], 1u);
            const unsigned tg = og / nx;
            if (og + 1u == (tg + 1u) * nx) xb_add(&bar[XB_TOPGEN], 1u);
            else XB_SPIN(xb_ld(&bar[XB_TOPGEN]) == tg, bar);
            __builtin_amdgcn_fence(__ATOMIC_ACQUIRE, "agent");
            xb_add(&bar[XB_XGEN(b.x)], 1u);
            asm volatile("s_waitcnt vmcnt(0)" ::: "memory");
        } else {
            XB_SPIN(xb_ld(&bar[XB_XGEN(b.x)]) == gen, bar);
            __builtin_amdgcn_fence(__ATOMIC_ACQUIRE, "agent");
            asm volatile("s_waitcnt vmcnt(0)" ::: "memory");
        }
    }
    __syncthreads();
}

struct Args {
    const float* x; const float* c; const float* ctx; const float* c_ctx; const float* w_mod; const float* b_mod; const float* ln_g; const float* ln_b;
    const float* a_w_qkv; const float* a_sink; const float* a_w_o; const float* b_w_qkv; const float* lq1; const float* lk1; const float* lq2; const float* lk2;
    const float* subln; const float* b_w_o; const float* ff_g; const float* ff_u; const float* ff_d; const float* moe_r; const float* moe_g; const float* moe_u; const float* moe_d;
    float* out; unsigned char* ws; int ph_lo, ph_hi;
};

__device__ __forceinline__ void transpose_item(const float* W, int K, int N, bf16_t* WT, int drow0, LAS float* scr, int k0, int n0, int lane) {
#pragma unroll 8
    for (int i = 0; i < 32; ++i) { const int kk = 2 * i + (lane >> 5); scr[kk * 33 + (lane & 31)] = W[(size_t)(k0 + kk) * N + n0 + (lane & 31)]; }
    LDS_WAIT(); asm volatile("" ::: "memory");
    const int c = lane & 7;
#pragma unroll
    for (int j = 0; j < 4; ++j) { const int n = (lane >> 3) + 8 * j; const LAS float* s = scr + (8 * c) * 33 + n;
        u32x4 o; o.x = cvt_pk_bf16(s[0 * 33], s[1 * 33]); o.y = cvt_pk_bf16(s[2 * 33], s[3 * 33]); o.z = cvt_pk_bf16(s[4 * 33], s[5 * 33]); o.w = cvt_pk_bf16(s[6 * 33], s[7 * 33]);
        *(u32x4*)(WT + (size_t)(drow0 + n) * K + k0 + 8 * c) = o; }
    LDS_WAIT(); asm volatile("" ::: "memory");
}
__device__ __forceinline__ void convert_mats(const float* src, int K, int N, int nmat, bf16_t* dst, int mode, LAS float* scr, int gw, int NGW, int& rot, int lane) {
    const int nnb = N / 32, ipm = (K / 64) * nnb, total = nmat * ipm;
    const size_t dstride = (size_t)(mode ? 2 * N : N) * K;
    int start = gw - rot; if (start < 0) start += NGW;
    for (int it = start; it < total; it += NGW) {
        const int mat = it / ipm, r = it - mat * ipm, kb = r / nnb, nb = r - kb * nnb, n0 = nb * 32;
        const int drow0 = mode == 0 ? n0 : ((n0 >> 7) * 256 + (n0 & 127) + (mode == 2 ? 128 : 0));
        transpose_item(src + (size_t)mat * K * N, K, N, dst + (size_t)mat * dstride, drow0, scr, kb * 64, n0, lane);
    }
    rot = (rot + total) % NGW;
}

struct RowP {
    const bf16_t* xin_b;
    bf16_t* xout_b;
    float* xout_f;
    const bf16_t* F;
    const bf16_t* Fp;
    const float* mod_gate; const float* lg; const float* lb;
    const float* mod_sc; const float* mod_sh;
    bf16_t* H;
    const unsigned* tok;
    int two;
    const float* wr;
    unsigned* cnt;
    unsigned* tokw;
};

template <int CTRL> __device__ __forceinline__ float dpp_xadd(float v) { return v + __int_as_float(__builtin_amdgcn_update_dpp(0, __float_as_int(v), CTRL, 0xF, 0xF, true)); }
__device__ __forceinline__ float wave_allsum(float v) {
    v = dpp_xadd<0xB1>(v); v = dpp_xadd<0x4E>(v); v = dpp_xadd<0x141>(v); v = dpp_xadd<0x140>(v);
    { auto r = __builtin_amdgcn_permlane16_swap(__float_as_uint(v), __float_as_uint(v), false, false); v = __uint_as_float(r[0]) + __uint_as_float(r[1]); }
    { auto r = __builtin_amdgcn_permlane32_swap(__float_as_uint(v), __float_as_uint(v), false, false); v = __uint_as_float(r[0]) + __uint_as_float(r[1]); }
    return v;
}
__device__ __forceinline__ float router_reduce(const float (&lg)[8], int lane) {
    float s[4], t[2];
#pragma unroll
    for (int k = 0; k < 4; ++k) { auto r = __builtin_amdgcn_permlane32_swap(__float_as_uint(lg[k]), __float_as_uint(lg[k + 4]), false, false); s[k] = __uint_as_float(r[0]) + __uint_as_float(r[1]); }
#pragma unroll
    for (int k = 0; k < 2; ++k) { auto r = __builtin_amdgcn_permlane16_swap(__float_as_uint(s[k]), __float_as_uint(s[k + 2]), false, false); t[k] = __uint_as_float(r[0]) + __uint_as_float(r[1]); }
    const float snd = (lane & 1) ? t[0] : t[1], kp = (lane & 1) ? t[1] : t[0];
    float u = kp + __int_as_float(__builtin_amdgcn_update_dpp(0, __float_as_int(snd), 0xB1, 0xF, 0xF, true));
    u = dpp_xadd<0x4E>(u); u = dpp_xadd<0x124>(u); u = dpp_xadd<0x128>(u);
    return u;
}
template <bool TWO, bool OUTF>
__device__ __forceinline__ void row_phase(const RowP& P, int row_lo, int nrows, LAS unsigned char* lds, int tid, int lane, int wave, int half_rows) {
    const int rpb = nrows / GRID, brow0 = row_lo + (int)blockIdx.x, nj = rpb >> 3;
#define CB(jj) (8 * lane + 512 * ((jj) >> 1) + 4 * ((jj) & 1))
#define UNPK_LO(w4) ((f32x4){bf_lo((w4).x), bf_hi((w4).x), bf_lo((w4).y), bf_hi((w4).y)})
#define UNPK_HI(w4) ((f32x4){bf_lo((w4).z), bf_hi((w4).z), bf_lo((w4).w), bf_hi((w4).w)})
    LAS f32x4* wrl = (LAS f32x4*)lds;
    LAS int* ebuf = (LAS int*)(lds + 32768);
    __syncthreads();
    if (P.wr) {
        for (int idx = tid; idx < 2048; idx += 512) { const int l = idx & 63, hh = (idx >> 6) & 1, e4 = (idx >> 7) & 3, j = idx >> 9; const int d = 8 * l + 512 * (j >> 1) + 4 * (j & 1) + e4;
            wrl[idx] = *(const f32x4*)(P.wr + (size_t)d * 8 + hh * 4); }
    }
    LAS f32x4* lgl = (LAS f32x4*)(lds + 40960);
    LAS f32x4* lbl = (LAS f32x4*)(lds + 45056);
    if (tid < 256) { const int l = tid & 63, j = tid >> 6; const int c = 8 * l + 512 * (j >> 1) + 4 * (j & 1); lgl[tid] = *(const f32x4*)(P.lg + c); lbl[tid] = *(const f32x4*)(P.lb + c); }
    __syncthreads();
    const bool dense18 = nj == 18;
#define JOF(i_) (dense18 ? ((i_) < 16 ? 16 * wave + (i_) : 128 + 2 * wave + ((i_) - 16)) : wave * nj + (i_))
    u32x4 a_x[2], a_fa[2], a_fb[2], b_x[2], b_fa[2], b_fb[2], pa[6], pb[6];
    int a_row, a_r1, a_r2, b_row, b_r1, b_r2; float a_w1, a_w2, b_w1, b_w2;
    f32x4 gv[4], scv[4], shv[4]; int m_cur = -1;
#define RP_FILL(S, i_) { \
        const int row_ = brow0 + GRID * JOF(i_); S##_row = row_; S##_r1 = row_; S##_r2 = row_; S##_w1 = 1.f; S##_w2 = 0.f; \
        if (TWO) { S##_r1 = (int)P.tok[TOK_SLOT + 2 * row_]; S##_r2 = (int)P.tok[TOK_SLOT + 2 * row_ + 1]; S##_w1 = __uint_as_float(P.tok[TOK_W + 2 * row_]); S##_w2 = __uint_as_float(P.tok[TOK_W + 2 * row_ + 1]); } \
        _Pragma("unroll") for (int p = 0; p < 2; ++p) { const int c8 = 8 * lane + 512 * p; \
            S##_x[p] = *(const u32x4*)(P.xin_b + (size_t)row_ * D + c8); S##_fa[p] = *(const u32x4*)(P.F + (size_t)S##_r1 * D + c8); \
            if (TWO) S##_fb[p] = *(const u32x4*)(P.F + (size_t)S##_r2 * D + c8); } }
#define RP_PART(S) { \
        if (S##_r1 >= SPLIT_ROW0) { _Pragma("unroll") for (int pp = 0; pp < 3; ++pp) _Pragma("unroll") for (int p = 0; p < 2; ++p) pa[2 * pp + p] = *(const u32x4*)(P.Fp + (size_t)pp * PART_STRIDE + (size_t)S##_r1 * D + 8 * lane + 512 * p); } \
        if (TWO && S##_r2 >= SPLIT_ROW0) { _Pragma("unroll") for (int pp = 0; pp < 3; ++pp) _Pragma("unroll") for (int p = 0; p < 2; ++p) pb[2 * pp + p] = *(const u32x4*)(P.Fp + (size_t)pp * PART_STRIDE + (size_t)S##_r2 * D + 8 * lane + 512 * p); } }
    u32x4 ox[2], oh[2]; f32x4 of[4]; int o_row = 0;
    const __amdgpu_buffer_rsrc_t rs_x = __builtin_amdgcn_make_buffer_rsrc(OUTF ? (void*)P.xout_f : (void*)P.xout_b, 0, 0x7fffffff, 0x00020000);
    const __amdgpu_buffer_rsrc_t rs_h = __builtin_amdgcn_make_buffer_rsrc((void*)P.H, 0, 0x7fffffff, 0x00020000);
#define RP_STORE() { _Pragma("unroll") for (int p = 0; p < 2; ++p) { \
            if (OUTF) { __builtin_amdgcn_raw_buffer_store_b128(__builtin_bit_cast(u32x4, of[2 * p]), rs_x, lane * 32 + 2048 * p, o_row * 4096, 16); \
                        __builtin_amdgcn_raw_buffer_store_b128(__builtin_bit_cast(u32x4, of[2 * p + 1]), rs_x, lane * 32 + 2048 * p + 16, o_row * 4096, 16); } \
            else { __builtin_amdgcn_raw_buffer_store_b128(ox[p], rs_x, lane * 16 + 1024 * p, o_row * 2048, 16); __builtin_amdgcn_raw_buffer_store_b128(oh[p], rs_h, lane * 16 + 1024 * p, o_row * 2048, 16); } } }
#define RP_BODY(S, T, i_) { \
        const int c_row = S##_row; const int c_mrow = c_row < ML ? (c_row >> 11) : 16; \
        if (c_mrow != m_cur) { m_cur = c_mrow; \
            _Pragma("unroll") for (int j = 0; j < 4; ++j) { gv[j] = *(const f32x4*)(P.mod_gate + (size_t)c_mrow * NMOD + CB(j)); \
                if (!OUTF) { scv[j] = *(const f32x4*)(P.mod_sc + (size_t)c_mrow * NMOD + CB(j)); shv[j] = *(const f32x4*)(P.mod_sh + (size_t)c_mrow * NMOD + CB(j)); } } } \
        f32x4 v[4]; \
        _Pragma("unroll") for (int p = 0; p < 2; ++p) { \
            v[2 * p] = UNPK_LO(S##_fa[p]) * S##_w1; v[2 * p + 1] = UNPK_HI(S##_fa[p]) * S##_w1; \
            if (TWO) { v[2 * p] += UNPK_LO(S##_fb[p]) * S##_w2; v[2 * p + 1] += UNPK_HI(S##_fb[p]) * S##_w2; } } \
        if (S##_r1 >= SPLIT_ROW0) { \
            _Pragma("unroll") for (int pp = 0; pp < 3; ++pp) _Pragma("unroll") for (int p = 0; p < 2; ++p) { v[2 * p] += UNPK_LO(pa[2 * pp + p]) * S##_w1; v[2 * p + 1] += UNPK_HI(pa[2 * pp + p]) * S##_w1; } } \
        if (TWO && S##_r2 >= SPLIT_ROW0) { \
            _Pragma("unroll") for (int pp = 0; pp < 3; ++pp) _Pragma("unroll") for (int p = 0; p < 2; ++p) { v[2 * p] += UNPK_LO(pb[2 * pp + p]) * S##_w2; v[2 * p + 1] += UNPK_HI(pb[2 * pp + p]) * S##_w2; } } \
        _Pragma("unroll") for (int j = 0; j < 4; ++j) { const f32x4 xj = (j & 1) ? UNPK_HI(S##_x[j >> 1]) : UNPK_LO(S##_x[j >> 1]); v[j] = xj * DN_ALPHA + (gv[j] + 1.0f) * v[j]; } \
        if ((i_) > 0) RP_STORE();                                    \
        { const int i2_ = (i_) + 2 < nj ? (i_) + 2 : nj - 1; RP_FILL(S, i2_); }     \
        if ((i_) + 1 < nj) RP_PART(T); \
        float s = 0.f; \
        _Pragma("unroll") for (int j = 0; j < 4; ++j) s += (v[j][0] + v[j][1]) + (v[j][2] + v[j][3]); \
        const float mean = wave_allsum(s) * (1.f / D); \
        float s2 = 0.f; \
        _Pragma("unroll") for (int j = 0; j < 4; ++j) { v[j] = v[j] - mean; s2 += (v[j][0] * v[j][0] + v[j][1] * v[j][1]) + (v[j][2] * v[j][2] + v[j][3] * v[j][3]); } \
        const float rstd = 1.f / sqrtf(wave_allsum(s2) * (1.f / D) + LN_EPS); \
        o_row = c_row; \
        _Pragma("unroll") for (int p = 0; p < 2; ++p) { \
            const f32x4 xa = v[2 * p] * rstd * lgl[(2 * p) * 64 + lane] + lbl[(2 * p) * 64 + lane], xb = v[2 * p + 1] * rstd * lgl[(2 * p + 1) * 64 + lane] + lbl[(2 * p + 1) * 64 + lane]; \
            if (OUTF) { of[2 * p] = xa; of[2 * p + 1] = xb; } \
            else { \
                ox[p].x = cvt_pk_bf16(xa[0], xa[1]); ox[p].y = cvt_pk_bf16(xa[2], xa[3]); ox[p].z = cvt_pk_bf16(xb[0], xb[1]); ox[p].w = cvt_pk_bf16(xb[2], xb[3]); \
                const f32x4 ha = xa * (scv[2 * p] + 1.0f) + shv[2 * p], hb = xb * (scv[2 * p + 1] + 1.0f) + shv[2 * p + 1]; \
                oh[p].x = cvt_pk_bf16(ha[0], ha[1]); oh[p].y = cvt_pk_bf16(ha[2], ha[3]); oh[p].z = cvt_pk_bf16(hb[0], hb[1]); oh[p].w = cvt_pk_bf16(hb[2], hb[3]); \
                v[2 * p] = ha; v[2 * p + 1] = hb; } } \
        if (!OUTF && P.wr) { \
            float lg[8]; \
            _Pragma("unroll") for (int e = 0; e < 8; ++e) lg[e] = 0.f; \
            _Pragma("unroll") for (int j = 0; j < 4; ++j) _Pragma("unroll") for (int e4 = 0; e4 < 4; ++e4) { \
                const f32x4 wa = wrl[((j * 4 + e4) * 2 + 0) * 64 + lane], wb = wrl[((j * 4 + e4) * 2 + 1) * 64 + lane]; \
                _Pragma("unroll") for (int qq = 0; qq < 4; ++qq) { lg[qq] += v[j][e4] * wa[qq]; lg[4 + qq] += v[j][e4] * wb[qq]; } } \
            const float dd = router_reduce(lg, lane); \
            float lg8[8]; \
            _Pragma("unroll") for (int e = 0; e < 8; ++e) lg8[e] = __uint_as_float((unsigned)__builtin_amdgcn_readlane((int)__float_as_uint(dd), (e & 1) | (((e >> 1) & 1) << 4) | (((e >> 2) & 1) << 5))); \
            float v1 = lg8[0]; int e1 = 0; \
            _Pragma("unroll") for (int e = 1; e < 8; ++e) if (lg8[e] > v1) { v1 = lg8[e]; e1 = e; } \
            float v2 = -3.0e38f; int e2 = 0; \
            _Pragma("unroll") for (int e = 0; e < 8; ++e) if (e != e1 && lg8[e] > v2) { v2 = lg8[e]; e2 = e; } \
            const float ew = __expf(v2 - v1), wa_ = 1.0f / (1.0f + ew), wb_ = ew * wa_; \
            if (lane == 0) { ebuf[JOF(i_)] = e1 | (e2 << 8); P.tokw[TOK_E + c_row] = (unsigned)(e1 | (e2 << 8)); P.tokw[TOK_W + 2 * c_row] = __float_as_uint(wa_); P.tokw[TOK_W + 2 * c_row + 1] = __float_as_uint(wb_); } \
        } }
    RP_FILL(a, 0); { const int i1 = nj > 1 ? 1 : 0; RP_FILL(b, i1); } RP_PART(a);
    for (int i = 0; i < nj; i += 2) {
        RP_BODY(a, b, i);
        if (i + 1 >= nj) break;
        RP_BODY(b, a, i + 1);
    }
    RP_STORE();
#undef RP_FILL
#undef RP_PART
#undef RP_STORE
#undef RP_BODY
#undef JOF
    __syncthreads();
    if (P.wr) {
        if (tid < 16) { const int e = tid & 7, half = tid >> 3, j0 = half * (rpb >> 1); int c = 0;
            for (int j = j0; j < j0 + (rpb >> 1); ++j) { const int ee = ebuf[j]; const int row = brow0 + GRID * j;
                if ((ee & 255) == e) P.tokw[TOK_POS + 2 * row] = (unsigned)c++; if ((ee >> 8) == e) P.tokw[TOK_POS + 2 * row + 1] = (unsigned)c++; }
            P.tokw[TOK_BLK + (half * GRID + (int)blockIdx.x) * 8 + e] = (unsigned)c;
            if (c) __hip_atomic_fetch_add(P.cnt + half * 64 + e, (unsigned)c, __ATOMIC_RELAXED, __HIP_MEMORY_SCOPE_AGENT);
        }
        __syncthreads();
    }
}

#undef CB
#undef UNPK_LO
#undef UNPK_HI
typedef const __attribute__((address_space(4))) Args* KArgs;
__device__ __forceinline__ KArgs kargs() { unsigned long long p = (unsigned long long)__builtin_amdgcn_kernarg_segment_ptr(); asm volatile("" : "+s"(p)); return (KArgs)p; }

__device__ __forceinline__ void phase_prologue(LAS unsigned char* lds) {
    const KArgs a = kargs(); const int tid = fresh_tid(), lane = tid & 63, wave = __builtin_amdgcn_readfirstlane(tid >> 6);
    const int bid = blockIdx.x, G = gridDim.x; unsigned char* ws = a->ws;
    float* MOD = (float*)(ws + WS_MOD); float* ROPE = (float*)(ws + WS_ROPE);
    {
        LAS float* sc = (LAS float*)lds;
        LAS float* red = (LAS float*)(lds + 81920);
        const float* cc = a->c; const float* cctx = a->c_ctx;
        for (int idx = tid; idx < 17 * 1024; idx += 512) { const int r = idx >> 10, k = idx & 1023; const float v = r < 16 ? cc[r * 1024 + k] : cctx[k]; sc[k * 20 + r] = v / (1.0f + __expf(-v)); }
        __syncthreads();
        const float* wmod = a->w_mod; const float* bmod = a->b_mod;
        for (int item = bid; item < 4 * 96; item += G) {
            const int layer = item / 96, cb = item - layer * 96;
            const float* W = wmod + (size_t)layer * D * NMOD + cb * 64 + lane;
            float acc[17];
#pragma unroll
            for (int r = 0; r < 17; ++r) acc[r] = 0.f;
            for (int kb = 0; kb < 128; kb += 16) {
                float wv[16];
#pragma unroll
                for (int u = 0; u < 16; ++u) wv[u] = W[(size_t)(wave * 128 + kb + u) * NMOD];
#pragma unroll
                for (int u = 0; u < 16; ++u) { const int k = wave * 128 + kb + u; const float w = wv[u];
                    const f32x4 s0 = *(const LAS f32x4*)(sc + k * 20), s1 = *(const LAS f32x4*)(sc + k * 20 + 4), s2 = *(const LAS f32x4*)(sc + k * 20 + 8), s3 = *(const LAS f32x4*)(sc + k * 20 + 12); const float s4 = sc[k * 20 + 16];
#pragma unroll
                    for (int q = 0; q < 4; ++q) { acc[q] += w * s0[q]; acc[4 + q] += w * s1[q]; acc[8 + q] += w * s2[q]; acc[12 + q] += w * s3[q]; }
                    acc[16] += w * s4; } }
#pragma unroll
            for (int r = 0; r < 17; ++r) red[(wave * 17 + r) * 64 + lane] = acc[r];
            __syncthreads();
            for (int idx = tid; idx < 17 * 64; idx += 512) { const int r = idx >> 6, l = idx & 63; float s = 0.f;
#pragma unroll
                for (int w = 0; w < 8; ++w) s += red[(w * 17 + r) * 64 + l];
                MOD[((size_t)layer * 17 + r) * NMOD + cb * 64 + l] = s + bmod[layer * NMOD + cb * 64 + l]; }
            __syncthreads();
        }
    }
    if (bid == G - 1) {
        for (int idx = tid; idx < 1024; idx += 512) { const int pos = idx >> 4, i = idx & 15;
            const float inv = exp2f(-(float)(2 * i) * (13.287712379549449f / 32.0f)); const float ang = (float)pos * inv;
            ROPE[idx] = __cosf(ang); ROPE[1024 + idx] = __sinf(ang); }
        if (wave < 2) { const int j = wave; const float p1 = wave_sum(a->lq1[j * 64 + lane] * a->lk1[j * 64 + lane]), p2 = wave_sum(a->lq2[j * 64 + lane] * a->lk2[j * 64 + lane]);
            const float li = 0.8f - 0.6f * __expf(-0.3f * (float)(2 * j + 1));
            if (lane == 0) ROPE[2048 + j] = __expf(p1) - __expf(p2) + li; }
    }
    __syncthreads();
    {
        LAS float* scr = (LAS float*)(lds + wave * 8448);
        const int gw = bid * 8 + wave, NGW = G * 8; int rot = 0;
        convert_mats(a->a_w_qkv, D, NQA, 2, (bf16_t*)(ws + WS_WAQKV), 0, scr, gw, NGW, rot, lane);
        convert_mats(a->a_w_o, D, D, 2, (bf16_t*)(ws + WS_WAO), 0, scr, gw, NGW, rot, lane);
        convert_mats(a->b_w_qkv, D, NQB, 2, (bf16_t*)(ws + WS_WBQKV), 0, scr, gw, NGW, rot, lane);
        convert_mats(a->b_w_o, D, D, 2, (bf16_t*)(ws + WS_WBO), 0, scr, gw, NGW, rot, lane);
        convert_mats(a->ff_g, D, DFF, 2, (bf16_t*)(ws + WS_WFGU), 1, scr, gw, NGW, rot, lane);
        convert_mats(a->ff_u, D, DFF, 2, (bf16_t*)(ws + WS_WFGU), 2, scr, gw, NGW, rot, lane);
        convert_mats(a->ff_d, DFF, D, 2, (bf16_t*)(ws + WS_WFD), 0, scr, gw, NGW, rot, lane);
        convert_mats(a->moe_g, D, DFE, 16, (bf16_t*)(ws + WS_WMGU), 1, scr, gw, NGW, rot, lane);
        convert_mats(a->moe_u, D, DFE, 16, (bf16_t*)(ws + WS_WMGU), 2, scr, gw, NGW, rot, lane);
        convert_mats(a->moe_d, DFE, D, 16, (bf16_t*)(ws + WS_WMD), 0, scr, gw, NGW, rot, lane);
    }
    __syncthreads();
}

__device__ __forceinline__ void phase_mod0() {
    const KArgs a = kargs(); const int tid = fresh_tid(), lane = tid & 63, wave = __builtin_amdgcn_readfirstlane(tid >> 6);
    const int bid = blockIdx.x; unsigned char* ws = a->ws;
    const float* MOD = (const float*)(ws + WS_MOD); bf16_t* H = (bf16_t*)(ws + WS_H);
    const float* x = a->x; const float* ctx = a->ctx;
    const int rpb = MT / GRID;
    bf16_t* XB = (bf16_t*)(ws + WS_XB);
    for (int jr = wave; jr < rpb; jr += 16) {
        f32x4 xv[2][4]; int mr[2], rw[2];
#pragma unroll
        for (int q = 0; q < 2; ++q) { const int row = bid * rpb + jr + 8 * q; rw[q] = row; const bool lat = row < ML;
            const float* xr = lat ? x + (size_t)row * D : ctx + (size_t)(row - ML) * D; mr[q] = lat ? (row >> 11) : 16;
#pragma unroll
            for (int p = 0; p < 2; ++p) { xv[q][2 * p] = *(const f32x4*)(xr + 8 * lane + 512 * p); xv[q][2 * p + 1] = *(const f32x4*)(xr + 8 * lane + 512 * p + 4); } }
#pragma unroll
        for (int q = 0; q < 2; ++q)
#pragma unroll
            for (int p = 0; p < 2; ++p) { const int c8 = 8 * lane + 512 * p;
                const f32x4 sca = *(const f32x4*)(MOD + (size_t)mr[q] * NMOD + D + c8), scb = *(const f32x4*)(MOD + (size_t)mr[q] * NMOD + D + c8 + 4);
                const f32x4 sha = *(const f32x4*)(MOD + (size_t)mr[q] * NMOD + c8), shb = *(const f32x4*)(MOD + (size_t)mr[q] * NMOD + c8 + 4);
                const f32x4 xa = xv[q][2 * p], xb = xv[q][2 * p + 1];
                const f32x4 ha = xa * (sca + 1.0f) + sha, hb = xb * (scb + 1.0f) + shb;
                u32x4 w; w.x = cvt_pk_bf16(ha[0], ha[1]); w.y = cvt_pk_bf16(ha[2], ha[3]); w.z = cvt_pk_bf16(hb[0], hb[1]); w.w = cvt_pk_bf16(hb[2], hb[3]);
                *(u32x4*)(H + (size_t)rw[q] * D + c8) = w;
                u32x4 xw; xw.x = cvt_pk_bf16(xa[0], xa[1]); xw.y = cvt_pk_bf16(xa[2], xa[3]); xw.z = cvt_pk_bf16(xb[0], xb[1]); xw.w = cvt_pk_bf16(xb[2], xb[3]);
                *(u32x4*)(XB + (size_t)rw[q] * D + c8) = xw; }
    }
}

__device__ __forceinline__ void phase_qkv(LAS unsigned char* lds, int layer) {
    const KArgs a = kargs(); unsigned char* ws = a->ws;
    const bool typeB = layer & 1; const int j2 = layer >> 1; const int NQ = typeB ? NQB : NQA;
    const float* ROPE = (const float*)(ws + WS_ROPE);
    LAS float* rl = (LAS float*)(lds + RING_BYTES);
    { const int tid = fresh_tid(); *(LAS f32x4*)(rl + 4 * tid) = *(const f32x4*)(ROPE + 4 * tid); }
    __syncthreads();
    pg8::Gemm g{(const bf16_t*)(ws + WS_H), typeB ? (const bf16_t*)(ws + WS_WBQKV) + (size_t)j2 * NQB * D : (const bf16_t*)(ws + WS_WAQKV) + (size_t)j2 * NQA * D, D};
    pg8::GroupOrder S; S.init(MT / 256, NQ / 256, gridDim.x, blockIdx.x, D / 64);
    pg8::EpiQKV E{(bf16_t*)(ws + WS_BIG), NQ, typeB ? 8 : 5, 4, ML / 256, rl, rl + 1024};
    pg8::gemm_phase<pg8::EpiQKV, pg8::GroupOrder>(lds, g, S, E);
}

__device__ __forceinline__ void phase_attn(LAS unsigned char* lds, int layer) {
    const KArgs a = kargs(); unsigned char* ws = a->ws;
    const int tid = fresh_tid(); const int wave = __builtin_amdgcn_readfirstlane(tid >> 6);
    const bool typeB = layer & 1; const int j2 = layer >> 1; const bool with_ctx = layer < DEPTH - 1;
    const int bid = blockIdx.x; const int x8 = bid & 7, y = bid >> 3;
    const bf16_t* QKV = (const bf16_t*)(ws + WS_BIG); bf16_t* O = (bf16_t*)(ws + WS_H);
    const int sub = wave >> 2, w4 = wave & 3;
    if (!typeB) {
        const float* sink = a->a_sink;
        for (int i = 0; i < (with_ctx ? 9 : 8); ++i) {
            att::UnitD U; int b, p, n;
            if (i < 8) { const int bp = i * 16 + x8 * 2 + (y >> 4); b = bp >> 3; p = bp & 7; n = (y + 2 * i) & 15;
                const int j0 = n == 0 ? 2 : 0, j1 = n == 15 ? 4 : 6;
                U.qrow0 = b * SEQ + n * 128; U.n1 = 4; U.base1 = ML + b * CTXL; U.n2 = j1 - j0; U.base2 = b * SEQ + (n - 1) * 128 + 64 * j0;
                U.kp0 = (n - 1) * 128 + 64 * j0; U.qp0 = n * 128 + w4 * 32; U.masked = 1;
            } else { b = bid >> 4; p = (bid >> 1) & 7; n = bid & 1;
                U.qrow0 = ML + b * CTXL + n * 128; U.n1 = 4; U.base1 = ML + b * CTXL; U.n2 = 0; U.base2 = 0; U.kp0 = 0; U.qp0 = 0; U.masked = 0; }
            const int head = 2 * p + sub;
            U.qcol = head * 64; U.kcol = 1024 + (p >> 1) * 64; U.vcol = 1280 + (p >> 1) * 64; U.ocol = head * 64;
            U.sink2 = sink[j2 * 16 + head] * LOG2E; U.use_sink = 1; U.diag = nullptr;
            att::attn_unit<false>(lds, QKV, NQA, O, U, 0.f, 0.f, nullptr);
        }
    } else {
        const float lam = ((const float*)(ws + WS_ROPE))[2048 + j2];
        const float post = 1.0f - (0.8f - 0.6f * __expf(-0.3f * (float)layer));
        const float* subln = a->subln + j2 * 128;
        for (int i = 0; i < (with_ctx ? 9 : 8); ++i) {
            att::UnitD U; int b, p, n;
            if (i < 8) { const int bp = i * 16 + x8 * 2 + (y >> 4); b = bp >> 3; p = bp & 7; n = y & 15;
                U.qrow0 = b * SEQ + n * 128; U.n1 = 32; U.base1 = b * SEQ; U.n2 = 4; U.base2 = ML + b * CTXL;
            } else { b = bid >> 4; p = (bid >> 1) & 7; n = bid & 1;
                U.qrow0 = ML + b * CTXL + n * 128; U.n1 = 4; U.base1 = ML + b * CTXL; U.n2 = 0; U.base2 = 0; }
            U.kp0 = 0; U.qp0 = 0; U.masked = 0; U.sink2 = 0.f; U.use_sink = 0; U.diag = (DIAG_SEL && bid == 0 && i == 3 && layer == 1) ? (unsigned*)(ws + WS_CTL) + 16384 : nullptr;
            U.qcol = (2 * p + sub) * 64; U.kcol = 1024 + 2 * p * 64; U.vcol = 2048 + p * 128; U.ocol = p * 128;
            att::attn_unit<true>(lds, QKV, NQB, O, U, lam, post, subln);
        }
    }
    __syncthreads();
}

__device__ __forceinline__ void phase_oproj(LAS unsigned char* lds, int layer) {
    const KArgs a = kargs(); unsigned char* ws = a->ws;
    const bool typeB = layer & 1; const int j2 = layer >> 1; const int rows_out = (layer < DEPTH - 1) ? MT : ML;
    pg8::Gemm g{(const bf16_t*)(ws + WS_H), typeB ? (const bf16_t*)(ws + WS_WBO) + (size_t)j2 * D * D : (const bf16_t*)(ws + WS_WAO) + (size_t)j2 * D * D, D};
    pg8::GroupOrder S; S.init(rows_out / 256, D / 256, gridDim.x, blockIdx.x, D / 64, NSPLIT_TILE0);
    pg8::EpiBf16 E{(bf16_t*)(ws + WS_BIG), D, (bf16_t*)(ws + WS_PARTS) - (size_t)SPLIT_ROW0 * D, PART_STRIDE};
    pg8::gemm_phase<pg8::EpiBf16, pg8::GroupOrder>(lds, g, S, E);
}

__device__ __forceinline__ void phase_ln1(LAS unsigned char* lds, int layer, bool dummy = false) {
    const KArgs a = kargs(); unsigned char* ws = a->ws;
    const int tid = fresh_tid(), lane = tid & 63, wave = __builtin_amdgcn_readfirstlane(tid >> 6);
    const bool typeB = layer & 1; const int j2 = layer >> 1; const int rows_out = (layer < DEPTH - 1) ? MT : ML;
    const float* modL = (const float*)(ws + WS_MOD) + (size_t)layer * 17 * NMOD;
    RowP P; P.xin_b = (const bf16_t*)(ws + WS_XB); P.xout_b = (bf16_t*)(ws + WS_XB); P.xout_f = nullptr;
    P.F = (const bf16_t*)(ws + WS_BIG); P.Fp = (const bf16_t*)(ws + WS_PARTS) - (size_t)SPLIT_ROW0 * D; P.mod_gate = modL + 2 * D; P.lg = a->ln_g + (layer * 2 + 0) * D; P.lb = a->ln_b + (layer * 2 + 0) * D;
    P.mod_sc = modL + 4 * D; P.mod_sh = modL + 3 * D; P.H = (bf16_t*)(ws + WS_H); P.tok = nullptr; P.two = 0;
    P.wr = typeB ? a->moe_r + (size_t)j2 * D * 8 : nullptr; P.cnt = (unsigned*)(ws + WS_CTL) + CW_CNT + j2 * 128; P.tokw = (unsigned*)(ws + WS_TOK);
    if (dummy) { P.wr = nullptr; P.xout_b = (bf16_t*)(ws + WS_END); P.H = (bf16_t*)(ws + WS_END); }
    row_phase<false, false>(P, 0, rows_out, lds, tid, lane, wave, rows_out / 2);
}

__device__ __forceinline__ void tile_starts(const unsigned char* ws, bool typeB, int j2, int half, int hrows, int (&ts)[9]) {
    ts[0] = 0;
    if (typeB) { const unsigned* cnt = (const unsigned*)(ws + WS_CTL) + CW_CNT + j2 * 128 + half * 64;
#pragma unroll
        for (int e = 0; e < 8; ++e) ts[e + 1] = ts[e] + (int)((__builtin_amdgcn_readfirstlane(cnt[e]) + 255u) >> 8);
    } else {
#pragma unroll
        for (int e = 0; e < 8; ++e) ts[e + 1] = hrows / 256; }
}

__device__ __forceinline__ void phase_gather(LAS unsigned char* lds, int layer, int half) {
    const KArgs a = kargs(); unsigned char* ws = a->ws;
    const int tid = fresh_tid(), lane = tid & 63, wave = __builtin_amdgcn_readfirstlane(tid >> 6);
    const int j2 = layer >> 1; const int rows_out = (layer < DEPTH - 1) ? MT : ML; const int hrows = rows_out / 2, row_lo = half * hrows;
    int ts[9]; tile_starts(ws, true, j2, half, hrows, ts);
    unsigned* TOK = (unsigned*)(ws + WS_TOK); const bf16_t* H = (const bf16_t*)(ws + WS_H); bf16_t* HG = (bf16_t*)(ws + (half ? WS_HG1 : WS_BIG));
    const int rpb = hrows / GRID;
    LAS unsigned* bs = (LAS unsigned*)lds;
    { const int bb = (int)blockIdx.x;
      if (wave == 0) { unsigned a8[8];
#pragma unroll
          for (int e = 0; e < 8; ++e) a8[e] = 0u;
#pragma unroll
          for (int k = 0; k < 4; ++k) { const int b = lane + 64 * k; const u32x4 c0 = *(const u32x4*)(TOK + TOK_BLK + (half * GRID + b) * 8), c1 = *(const u32x4*)(TOK + TOK_BLK + (half * GRID + b) * 8 + 4);
              if (b < bb) { a8[0] += c0.x; a8[1] += c0.y; a8[2] += c0.z; a8[3] += c0.w; a8[4] += c1.x; a8[5] += c1.y; a8[6] += c1.z; a8[7] += c1.w; } }
#pragma unroll
          for (int e = 0; e < 8; ++e) {
#pragma unroll
              for (int o = 1; o < 64; o <<= 1) a8[e] += __shfl_xor(a8[e], o);
              if (lane == 0) bs[e] = a8[e]; } }
      __syncthreads(); }
    unsigned base8[8];
#pragma unroll
    for (int e = 0; e < 8; ++e) base8[e] = bs[e];
    unsigned short* RIDX = (unsigned short*)(ws + WS_CTL + CTL_RIDX) + (size_t)half * RIDX_HALF;
    for (int jr = tid; jr < rpb; jr += 512) {
        const int row = row_lo + (int)blockIdx.x + GRID * jr;
        const unsigned ee = TOK[TOK_E + row]; const int e1 = ee & 255, e2 = ee >> 8;
        int t1 = 0, t2 = 0;
#pragma unroll
        for (int e = 0; e < 8; ++e) { t1 = (e1 == e) ? ts[e] * 256 + (int)base8[e] : t1; t2 = (e2 == e) ? ts[e] * 256 + (int)base8[e] : t2; }
        const int s1 = t1 + (int)TOK[TOK_POS + 2 * row], s2 = t2 + (int)TOK[TOK_POS + 2 * row + 1];
        TOK[TOK_SLOT + 2 * row] = (unsigned)s1; TOK[TOK_SLOT + 2 * row + 1] = (unsigned)s2;
        RIDX[s1] = (unsigned short)row; RIDX[s2] = (unsigned short)row; }
}

__device__ __forceinline__ void phase_gu(LAS unsigned char* lds, int layer, int half) {
    const KArgs a = kargs(); unsigned char* ws = a->ws;
    const bool typeB = layer & 1; const int j2 = layer >> 1; const int rows_out = (layer < DEPTH - 1) ? MT : ML; const int hrows = typeB ? rows_out / 2 : rows_out;
    int ts[9]; tile_starts(ws, typeB, j2, half, hrows, ts);
    const int dff = typeB ? DFE : DFF;
    pg8::Gemm g{(const bf16_t*)(ws + WS_H), typeB ? (const bf16_t*)(ws + WS_WMGU) + (size_t)j2 * NEXP * 2 * DFE * D : (const bf16_t*)(ws + WS_WFGU) + (size_t)j2 * 2 * DFF * D, D};
    pg8::GroupOrder S; S.init(ts[8], 2 * dff / 256, gridDim.x, blockIdx.x, D / 64);
    pg8::EpiSwiglu E{(bf16_t*)(ws + WS_HID), dff};
    if (typeB) { S.ts1 = ts[1]; S.ts2 = ts[2]; S.ts3 = ts[3]; S.ts4 = ts[4]; S.ts5 = ts[5]; S.ts6 = ts[6]; S.ts7 = ts[7];
        pg8::gemm_phase<pg8::EpiSwiglu, pg8::GroupOrder, true>(lds, g, S, E, (const unsigned short*)(ws + WS_CTL + CTL_RIDX) + (size_t)half * RIDX_HALF);
    } else pg8::gemm_phase<pg8::EpiSwiglu, pg8::GroupOrder, false>(lds, g, S, E);
}

__device__ __forceinline__ void phase_down(LAS unsigned char* lds, int layer, int half) {
    const KArgs a = kargs(); unsigned char* ws = a->ws;
    const bool typeB = layer & 1; const int j2 = layer >> 1; const int rows_out = (layer < DEPTH - 1) ? MT : ML; const int hrows = typeB ? rows_out / 2 : rows_out;
    int ts[9]; tile_starts(ws, typeB, j2, half, hrows, ts);
    const int dff = typeB ? DFE : DFF;
    pg8::Gemm g{(const bf16_t*)(ws + WS_HID), typeB ? (const bf16_t*)(ws + WS_WMD) + (size_t)j2 * NEXP * D * DFE : (const bf16_t*)(ws + WS_WFD) + (size_t)j2 * D * DFF, dff};
    pg8::GroupOrder S; S.init(ts[8], D / 256, gridDim.x, blockIdx.x, dff / 64, NSPLIT_TILE0);
    if (typeB) { S.ts1 = ts[1]; S.ts2 = ts[2]; S.ts3 = ts[3]; S.ts4 = ts[4]; S.ts5 = ts[5]; S.ts6 = ts[6]; S.ts7 = ts[7]; }
    pg8::EpiBf16 E{(bf16_t*)(ws + WS_BIG), D, (bf16_t*)(ws + WS_PARTS) - (size_t)SPLIT_ROW0 * D, PART_STRIDE};
    pg8::gemm_phase<pg8::EpiBf16, pg8::GroupOrder>(lds, g, S, E);
}

__device__ __forceinline__ void phase_ln2(LAS unsigned char* lds, int layer, int half, bool dummy = false) {
    const KArgs a = kargs(); unsigned char* ws = a->ws;
    const int tid = fresh_tid(), lane = tid & 63, wave = __builtin_amdgcn_readfirstlane(tid >> 6);
    const bool typeB = layer & 1; const int rows_out = (layer < DEPTH - 1) ? MT : ML; const int hrows = typeB ? rows_out / 2 : rows_out;
    const float* modL = (const float*)(ws + WS_MOD) + (size_t)layer * 17 * NMOD; const float* modN = modL + 17 * NMOD;
    RowP P; P.xin_b = (const bf16_t*)(ws + WS_XB); const bool lastsub = layer + 1 == DEPTH; P.xout_b = lastsub ? nullptr : (bf16_t*)(ws + WS_XB); P.xout_f = a->out;
    P.F = (const bf16_t*)(ws + WS_BIG); P.Fp = (const bf16_t*)(ws + WS_PARTS) - (size_t)SPLIT_ROW0 * D; P.mod_gate = modL + 5 * D; P.lg = a->ln_g + (layer * 2 + 1) * D; P.lb = a->ln_b + (layer * 2 + 1) * D;
    const bool nextmod = layer + 1 < DEPTH;
    P.mod_sc = nextmod ? modN + D : nullptr; P.mod_sh = nextmod ? modN : nullptr; P.H = (bf16_t*)(ws + WS_H); P.tok = (const unsigned*)(ws + WS_TOK); P.two = typeB ? 1 : 0;
    P.wr = nullptr; P.cnt = nullptr; P.tokw = nullptr;
    if (dummy) { P.xout_b = (bf16_t*)(ws + WS_END); P.H = (bf16_t*)(ws + WS_END); }
    if (!typeB) row_phase<false, false>(P, half * hrows, hrows, lds, tid, lane, wave, hrows);
    else if (nextmod) row_phase<true, false>(P, half * hrows, hrows, lds, tid, lane, wave, hrows);
    else row_phase<true, true>(P, half * hrows, hrows, lds, tid, lane, wave, hrows);
}

__global__ void __launch_bounds__(512, 2) dit_fwd(Args a_unused) {
    extern __shared__ __attribute__((aligned(16))) unsigned char lds_raw[];
    LAS unsigned char* lds = (LAS unsigned char*)lds_raw;
    volatile LAS unsigned* MISC = (volatile LAS unsigned*)(lds + MISC_OFF);
    for (int u = threadIdx.x; u < (LDS_BYTES - LDSCTL_OFF) / 4; u += 512) ((LAS unsigned*)(lds + LDSCTL_OFF))[u] = 0u;
    __syncthreads();
    int ph_lo, ph_hi;
    XcdBarrier bar;
    { const KArgs a = kargs(); ph_lo = a->ph_lo; ph_hi = a->ph_hi; bar = xcd_barrier_post((unsigned*)(a->ws + WS_CTL) + CW_BAR, MISC + 8); }
    int ph = 0; unsigned long long dbar = 0;
#define PH_ON (ph >= ph_lo && ph < ph_hi)
#define PH_END do { const bool _both = (ph >= ph_lo) && (ph + 1 < ph_hi); ++ph; if (_both) { unsigned long long _b0 = 0; if (DIAG_SEL >= 12) _b0 = __builtin_amdgcn_s_memrealtime(); xcd_barrier(bar); if (DIAG_SEL >= 12) dbar += __builtin_amdgcn_s_memrealtime() - _b0; if (PROBE_MASK & 32) xcd_barrier(bar); } } while (0)
    if (PH_ON) { phase_prologue(lds); if (PROBE_MASK & 16) phase_prologue(lds); }
    PH_END;
    if (PH_ON) { phase_mod0(); if (PROBE_MASK & 64) phase_mod0(); }
    PH_END;
    for (int layer = 0; layer < DEPTH; ++layer) {
        if (PH_ON) { phase_qkv(lds, layer); if (PROBE_MASK & 1) phase_qkv(lds, layer); }
        PH_END;
        if (PH_ON) { phase_attn(lds, layer); if ((PROBE_MASK & 8) || ((PROBE_MASK & 128) && (layer & 1)) || ((PROBE_MASK & 256) && !(layer & 1))) phase_attn(lds, layer); }
        PH_END;
        if (PH_ON) { phase_oproj(lds, layer); if (PROBE_MASK & 1) phase_oproj(lds, layer); }
        PH_END;
        if (PH_ON) { phase_ln1(lds, layer); if (PROBE_MASK & 64) phase_ln1(lds, layer, true); }
        PH_END;
        if (!(layer & 1)) {
            if (PH_ON) { phase_gu(lds, layer, 0); if (PROBE_MASK & 2) phase_gu(lds, layer, 0); }
            PH_END;
            if (PH_ON) { phase_down(lds, layer, 0); if (PROBE_MASK & 4) phase_down(lds, layer, 0); }
            PH_END;
            if (PH_ON) { phase_ln2(lds, layer, 0); if (PROBE_MASK & 64) phase_ln2(lds, layer, 0, true); }
            PH_END;
        } else {
            if (PH_ON) { phase_gather(lds, layer, 0); __syncthreads(); phase_gather(lds, layer, 1); }
            PH_END;
            if (PH_ON) phase_gu(lds, layer, 0);
            PH_END;
            if (PH_ON) phase_down(lds, layer, 0);
            PH_END;
            if (PH_ON) { if (blockIdx.x & 1) { phase_gu(lds, layer, 1); phase_ln2(lds, layer, 0); } else { phase_ln2(lds, layer, 0); phase_gu(lds, layer, 1); } }
            PH_END;
            if (PH_ON) phase_down(lds, layer, 1);
            PH_END;
            if (PH_ON) phase_ln2(lds, layer, 1);
            PH_END;
        }
    }
#undef PH_ON
#undef PH_END
    if (DIAG_SEL >= 12 && threadIdx.x == 0 && (blockIdx.x == (DIAG_SEL == 12 ? 0 : (DIAG_SEL == 13 ? 100 : 255)))) { const KArgs a = kargs(); __hip_atomic_store((unsigned*)(a->ws + WS_CTL) + 16384 + DIAG_SEL, (unsigned)(dbar >> 3), __ATOMIC_RELAXED, __HIP_MEMORY_SCOPE_AGENT); }
    if (DIAG_SEL >= 12) { __syncthreads(); if (blockIdx.x == 0) { xcd_barrier(bar); } else xcd_barrier(bar); }
    if (DIAG_SEL && blockIdx.x == 0 && threadIdx.x == 0) { const KArgs a = kargs(); const unsigned d = __hip_atomic_load((unsigned*)(a->ws + WS_CTL) + 16384 + DIAG_SEL, __ATOMIC_RELAXED, __HIP_MEMORY_SCOPE_AGENT);
        const unsigned long long t0 = __builtin_amdgcn_s_memrealtime(); while (__builtin_amdgcn_s_memrealtime() - t0 < 16ull * d) __builtin_amdgcn_s_sleep(8); }
}

constexpr int NPHASES = 2 + 2 * (4 + 3) + 2 * (4 + 6);

extern "C" void kernel_launch(void* const* d_in, const int* in_sizes, int n_in, void* d_out, int out_size, void* d_ws, size_t ws_size, hipStream_t stream) {
    static int ready = 0;
    if (ready == 0) {
        if (n_in != 25 || out_size != ML * D || ws_size < WS_END) { fprintf(stderr, "kernel_launch: unexpected shapes (n_in %d out %d ws %zu); nothing launched\n", n_in, out_size, ws_size); ready = -1; return; }
        int dev = 0, cus = 0, per_cu = 0;
        if (hipGetDevice(&dev) != hipSuccess || hipDeviceGetAttribute(&cus, hipDeviceAttributeMultiprocessorCount, dev) != hipSuccess) { ready = -1; return; }
        if (hipFuncSetAttribute((const void*)dit_fwd, hipFuncAttributeMaxDynamicSharedMemorySize, LDS_BYTES) != hipSuccess) { fprintf(stderr, "kernel_launch: hipFuncSetAttribute failed\n"); ready = -1; return; }
        if (hipOccupancyMaxActiveBlocksPerMultiprocessor(&per_cu, (const void*)dit_fwd, 512, LDS_BYTES) != hipSuccess || per_cu < 1) fprintf(stderr, "kernel_launch: occupancy query reports %d\n", per_cu);
        (void)hipGetLastError();
        if (cus < GRID) { fprintf(stderr, "kernel_launch: %d CUs < %d; nothing launched\n", cus, GRID); ready = -1; return; }
        ready = 1;
    }
    if (ready < 0) return;
    if (hipMemsetAsync((char*)d_ws + WS_CTL, 0, CTL_ZERO_BYTES, stream) != hipSuccess) return;
    Args a{};
    a.x = (const float*)d_in[0]; a.c = (const float*)d_in[1]; a.ctx = (const float*)d_in[2]; a.c_ctx = (const float*)d_in[3]; a.w_mod = (const float*)d_in[4]; a.b_mod = (const float*)d_in[5];
    a.ln_g = (const float*)d_in[6]; a.ln_b = (const float*)d_in[7]; a.a_w_qkv = (const float*)d_in[8]; a.a_sink = (const float*)d_in[9]; a.a_w_o = (const float*)d_in[10];
    a.b_w_qkv = (const float*)d_in[11]; a.lq1 = (const float*)d_in[12]; a.lk1 = (const float*)d_in[13]; a.lq2 = (const float*)d_in[14]; a.lk2 = (const float*)d_in[15];
    a.subln = (const float*)d_in[16]; a.b_w_o = (const float*)d_in[17]; a.ff_g = (const float*)d_in[18]; a.ff_u = (const float*)d_in[19]; a.ff_d = (const float*)d_in[20];
    a.moe_r = (const float*)d_in[21]; a.moe_g = (const float*)d_in[22]; a.moe_u = (const float*)d_in[23]; a.moe_d = (const float*)d_in[24];
    a.out = (float*)d_out; a.ws = (unsigned char*)d_ws;
#if MK_LAUNCH_MODE == 0
    a.ph_lo = 0; a.ph_hi = NPHASES;
    hipLaunchKernelGGL(dit_fwd, dim3(GRID), dim3(512), LDS_BYTES, stream, a);
#else
    for (int k = 0; k < NPHASES; ++k) { a.ph_lo = k; a.ph_hi = k + 1; hipLaunchKernelGGL(dit_fwd, dim3(GRID), dim3(512), LDS_BYTES, stream, a); }
#endif
    const hipError_t le = hipPeekAtLastError();
    if (le != hipSuccess) fprintf(stderr, "kernel_launch: launch failed: %s\n", hipGetErrorName(le));
}
```

```cpp
#include <hip/hip_runtime.h>
#include <cstdio>
#include <cstdint>

#ifndef MK_LAUNCH_MODE
#define MK_LAUNCH_MODE 0
#endif

#ifndef PROBE_MASK
#define PROBE_MASK 0
#endif
#ifndef ATT_PROBE
#define ATT_PROBE 0
#endif
#ifndef DIAG_SEL
#define DIAG_SEL 0
#endif
#ifndef DIAG_WAVE
#define DIAG_WAVE 0
#endif
#define LAS __attribute__((address_space(3)))
#define GAS __attribute__((address_space(1)))
typedef unsigned short bf16_t;
typedef short bf16x8 __attribute__((ext_vector_type(8)));
typedef short s16x4 __attribute__((ext_vector_type(4)));
typedef float f32x4 __attribute__((ext_vector_type(4)));
typedef float f32x2 __attribute__((ext_vector_type(2)));
typedef float f32x16 __attribute__((ext_vector_type(16)));
typedef unsigned u32x4 __attribute__((ext_vector_type(4)));
typedef unsigned u32x2 __attribute__((ext_vector_type(2)));

constexpr int D = 1024, NBATCH = 16, SEQ = 2048, CTXL = 256, DEPTH = 4;
constexpr int ML = NBATCH * SEQ;
constexpr int MC = NBATCH * CTXL;
constexpr int MT = ML + MC;
constexpr int DFF = 2816, NEXP = 8, DFE = 3584;
constexpr int NQA = 1536, NQB = 3072;
constexpr int NMOD = 6 * D;
constexpr float LN_EPS = 1e-5f, RMS_EPS = 1e-5f;
constexpr float DN_ALPHA = 1.681792830507429f;
constexpr float QSCALE = 0.125f * 1.4426950408889634f;
constexpr float LOG2E = 1.4426950408889634f;
constexpr int GRID = 256;

constexpr size_t MiB = 1u << 20;
constexpr size_t WS_CTL = 0, CTL_ZERO_BYTES = 1 * MiB;
constexpr size_t WS_MOD = 1 * MiB;
constexpr size_t WS_ROPE = 3 * MiB;
constexpr size_t WS_TOK = 4 * MiB;
constexpr size_t WS_XC = 8 * MiB;
constexpr size_t WS_WAQKV = 24 * MiB;
constexpr size_t WS_WAO = 30 * MiB;
constexpr size_t WS_WBQKV = 34 * MiB;
constexpr size_t WS_WBO = 46 * MiB;
constexpr size_t WS_WFGU = 50 * MiB;
constexpr size_t WS_WFD = 72 * MiB;
constexpr size_t WS_WMGU = 84 * MiB;
constexpr size_t WS_WMD = 308 * MiB;
constexpr size_t WS_H = 420 * MiB;
constexpr size_t WS_BIG = 492 * MiB;
constexpr size_t WS_HID = 568 * MiB;
constexpr size_t WS_PARTS = 834 * MiB;
constexpr size_t WS_XB = 872 * MiB;
constexpr size_t WS_HG1 = 944 * MiB;
constexpr size_t WS_END = 1020 * MiB;
constexpr int NSPLIT_TILE0 = 128, SPLIT_ROW0 = NSPLIT_TILE0 * 256;
constexpr size_t PART_STRIDE = (size_t)6144 * 1024;
static_assert(WS_WFD + (size_t)2 * 1024 * 2816 * 2 <= WS_WMGU, "ws map");
static_assert(WS_WMGU + (size_t)2 * 8 * 7168 * 1024 * 2 <= WS_WMD, "ws map");
static_assert(WS_WMD + (size_t)2 * 8 * 1024 * 3584 * 2 <= WS_H, "ws map");
static_assert(WS_BIG + (size_t)MT * NQB * 2 <= WS_END && WS_HID + (size_t)38912 * DFE * 2 <= WS_END, "ws map");
constexpr int TOK_E = 0, TOK_W = MT, TOK_POS = 3 * MT, TOK_SLOT = 5 * MT;
constexpr int TOK_BLK = 7 * MT;
constexpr int CW_BAR = 4096;
constexpr int CW_CNT = 8192;
constexpr size_t CTL_RIDX = 262144;
constexpr int RIDX_HALF = 38912;

constexpr int RING_BYTES = 131072;
constexpr int LDSCTL_OFF = 143360, MISC_OFF = LDSCTL_OFF + 320;
constexpr int LDS_BYTES = 147456;

#define LDS_WAIT() asm volatile("s_waitcnt lgkmcnt(0)" ::: "memory")
#define VM_WAIT() asm volatile("s_waitcnt vmcnt(0)" ::: "memory")

__device__ __forceinline__ unsigned cvt_pk_bf16(float lo, float hi) { unsigned r; asm volatile("v_cvt_pk_bf16_f32 %0, %1, %2" : "=v"(r) : "v"(lo), "v"(hi)); return r; }
typedef float f32x2_t __attribute__((ext_vector_type(2))); typedef __bf16 bf16x2_t __attribute__((ext_vector_type(2)));
__device__ __forceinline__ unsigned cvtpk_s(float lo, float hi) { f32x2_t v = {lo, hi}; bf16x2_t b = __builtin_convertvector(v, bf16x2_t); return __builtin_bit_cast(unsigned, b); }
__device__ __forceinline__ float bf_lo(unsigned w) { return __uint_as_float(w << 16); }
__device__ __forceinline__ float bf_hi(unsigned w) { return __uint_as_float(w & 0xffff0000u); }
__device__ __forceinline__ int fresh_tid() { int t = threadIdx.x; asm volatile("" : "+v"(t)); return t; }
__device__ __forceinline__ float wave_sum(float v) {
#pragma unroll
    for (int o = 1; o < 64; o <<= 1) v += __shfl_xor(v, o);
    return v;
}

namespace pg8 {
constexpr int BM = 256, BK = 64, HALF = 128, HTB = HALF * BK * 2, STAGE_BYTES = 8 * HTB, NXCD = 8, WGM = 8;
__host__ __device__ __forceinline__ int lds_byte(int r, int c) { const int st = (r >> 4) * 2 + (c >> 5), rr = r & 15, cc = c & 31, ob = rr * 64 + cc * 2; return st * 1024 + (ob ^ (((ob >> 9) & 1) << 5)); }
__host__ __device__ __forceinline__ void stage_rc(int b, int& R, int& C) { const int st = b / 1024, sb = b % 1024, swz = sb ^ (((sb >> 9) & 1) << 5); R = (st >> 1) * 16 + swz / 64; C = (st & 1) * 32 + (swz % 64) / 2; }
__host__ __device__ __forceinline__ int perm32(int rho) { const int n = rho >> 4, i = rho & 15; return 8 * (i >> 2) + 4 * n + (i & 3); }

struct Unit { int pm, pn, pb, kt0, nkt, part; };
struct Gemm { const bf16_t* A; const bf16_t* Bt; int K; unsigned* diag = nullptr; };

struct GroupOrder {
    int nM, nN, nwg, G, c, nMf, nfull, KT;
    int ts1, ts2, ts3, ts4, ts5, ts6, ts7;
    __device__ __forceinline__ void init(int nM_, int nN_, int G_, int c_, int KT_, int nMf_ = 0x7fffffff) {
        nM = nM_; nN = nN_; G = G_; c = c_; KT = KT_; nMf = nMf_ < nM_ ? nMf_ : nM_; nfull = nMf * nN; nwg = nfull + 4 * (nM - nMf) * nN;
        ts1 = ts2 = ts3 = ts4 = ts5 = ts6 = ts7 = 0x7fffffff; }
    __device__ __forceinline__ bool next(int i, Unit& u) const {
        const long L = (long)i * G + c; if (L >= nwg) return false;
        int pm, pn, kt0, nkt, part;
        if (L < nfull) {
            int wgid = (int)L; { const int q = nfull / NXCD, r = nfull % NXCD, xcd = wgid % NXCD, off = wgid / NXCD; wgid = (xcd < r ? xcd * (q + 1) : r * (q + 1) + (xcd - r) * q) + off; }
            const int nig = WGM * nN, gid = wgid / nig, fm = gid * WGM, gsz = (nMf - fm) < WGM ? (nMf - fm) : WGM;
            pm = fm + ((wgid % nig) % gsz); pn = (wgid % nig) / gsz; kt0 = 0; nkt = KT; part = 0;
        } else {
            const int Ls = (int)L - nfull, uu = Ls >> 2; part = Ls & 3;
            pm = nMf + uu / nN; pn = uu % nN;
            const int base = (KT >> 2) & ~1, rem2 = (KT - 4 * base) >> 1;
            nkt = base + (part < rem2 ? 2 : 0); kt0 = part * base + 2 * (part < rem2 ? part : rem2);
        }
        u.pm = pm; u.pn = pn; u.kt0 = kt0; u.nkt = nkt; u.part = part;
        const int e = (pm >= ts1) + (pm >= ts2) + (pm >= ts3) + (pm >= ts4) + (pm >= ts5) + (pm >= ts6) + (pm >= ts7);
        u.pb = e * nN + pn; return true;
    }
};

struct EpiBf16 {
    static constexpr bool PERM = true;
    bf16_t* O0; int ldc; bf16_t* Op; size_t pstride;
    __device__ __forceinline__ void operator()(const f32x4 (&acc)[2][2][4][2], const Unit& u, int wr, int wc, int fr, int fq) const {
        bf16_t* O = u.part == 0 ? O0 : Op + (size_t)(u.part - 1) * pstride;
        const int row0 = u.pm * BM + wr * 64 + fr, col0 = u.pn * BM + wc * 32 + 8 * fq;
#pragma unroll
        for (int ai = 0; ai < 2; ++ai)
#pragma unroll
            for (int m = 0; m < 4; ++m) { bf16_t* rowp = O + (size_t)(row0 + ai * HALF + m * 16) * ldc + col0;
#pragma unroll
                for (int bj = 0; bj < 2; ++bj) { const f32x4 v0 = acc[ai][bj][m][0], v1 = acc[ai][bj][m][1];
                    u32x4 w; w.x = cvtpk_s(v0[0], v0[1]); w.y = cvtpk_s(v0[2], v0[3]); w.z = cvtpk_s(v1[0], v1[1]); w.w = cvtpk_s(v1[2], v1[3]);
                    *(u32x4*)(rowp + bj * HALF) = w; } }
    }
};
struct EpiSwiglu {
    static constexpr bool PERM = true;
    bf16_t* O; int ldc;
    __device__ __forceinline__ void operator()(const f32x4 (&acc)[2][2][4][2], const Unit& u, int wr, int wc, int fr, int fq) const {
        const int row0 = u.pm * BM + wr * 64 + fr, col0 = u.pn * HALF + wc * 32 + 8 * fq;
#pragma unroll
        for (int ai = 0; ai < 2; ++ai)
#pragma unroll
            for (int m = 0; m < 4; ++m) { bf16_t* rowp = O + (size_t)(row0 + ai * HALF + m * 16) * ldc + col0;
                float h[8];
#pragma unroll
                for (int n = 0; n < 2; ++n)
#pragma unroll
                    for (int e = 0; e < 4; ++e) { const float g = acc[ai][0][m][n][e], up = acc[ai][1][m][n][e];
                        h[n * 4 + e] = g * __builtin_amdgcn_rcpf(1.0f + __builtin_amdgcn_exp2f(-LOG2E * g)) * up; }
                u32x4 w; w.x = cvt_pk_bf16(h[0], h[1]); w.y = cvt_pk_bf16(h[2], h[3]); w.z = cvt_pk_bf16(h[4], h[5]); w.w = cvt_pk_bf16(h[6], h[7]);
                *(u32x4*)rowp = w; }
    }
};
struct EpiQKV {
    static constexpr bool PERM = false;
    bf16_t* O; int ldc; int n_rope_tiles, n_q_tiles, n_lat_tiles; const LAS float* cosT; const LAS float* sinT;
    __device__ __forceinline__ void operator()(const f32x4 (&acc)[2][2][4][2], const Unit& u, int wr, int wc, int fr, int fq) const {
        const int row0 = u.pm * BM + wr * 64 + fr, col0 = u.pn * BM + wc * 32 + 4 * fq;
        const bool rope = (u.pn < n_rope_tiles) && (u.pm < n_lat_tiles);
        const float sc = (u.pn < n_q_tiles) ? QSCALE : 1.0f;
#pragma unroll
        for (int ai = 0; ai < 2; ++ai)
#pragma unroll
            for (int m = 0; m < 4; ++m) { const int row = row0 + ai * HALF + m * 16; bf16_t* rowp = O + (size_t)row * ldc + col0;
                f32x4 cs = (f32x4){1.f, 1.f, 1.f, 1.f}, sn = (f32x4){0.f, 0.f, 0.f, 0.f};
                if (rope) { const int t = row & (SEQ - 1); const int pos = (wc & 1) ? (t & 63) : (t >> 6);
                    cs = *(const LAS f32x4*)(cosT + pos * 16 + 4 * fq); sn = *(const LAS f32x4*)(sinT + pos * 16 + 4 * fq); }
#pragma unroll
                for (int bj = 0; bj < 2; ++bj) { const f32x4 x1 = acc[ai][bj][m][0], x2 = acc[ai][bj][m][1];
                    const f32x4 o1 = (x1 * cs - x2 * sn) * sc, o2 = (x2 * cs + x1 * sn) * sc;
                    u32x2 w1, w2; w1.x = cvt_pk_bf16(o1[0], o1[1]); w1.y = cvt_pk_bf16(o1[2], o1[3]); w2.x = cvt_pk_bf16(o2[0], o2[1]); w2.y = cvt_pk_bf16(o2[2], o2[3]);
                    *(u32x2*)(rowp + bj * HALF) = w1; *(u32x2*)(rowp + bj * HALF + 16) = w2; } }
    }
};

constexpr int GATHER_MAX_UNITS = 17;
template <class Epi, class Sched, bool GATHER = false>
__device__ __forceinline__ void gemm_phase(LAS unsigned char* lds, const Gemm g, const Sched& S, const Epi& E, const unsigned short* ridx = nullptr) {
    const int tid = fresh_tid(), wid = __builtin_amdgcn_readfirstlane(tid >> 6), lane = tid & 63, wr = wid >> 2, wc = wid & 3, fr = lane & 15, fq = lane >> 4;
    const int K = g.K;
    unsigned voffA[2], voffB[2];
#pragma unroll
    for (int i = 0; i < 2; ++i) { int R, C; stage_rc(tid * 16 + i * 8192, R, C); const int Rb = Epi::PERM ? ((R & ~31) + perm32(R & 31)) : R;
        voffA[i] = (unsigned)(R * K + C) * 2u; voffB[i] = (unsigned)(Rb * K + C) * 2u; }
    const size_t kstep = (size_t)(BK * 2);
    const size_t hstep = (size_t)HALF * K * 2;
    const size_t tstep = 2 * hstep;
    const unsigned ldsw = (unsigned)wid * 1024u;
    const int aoff = lds_byte(wr * 64 + fr, fq * 8), boff = lds_byte(wc * 32 + fr, fq * 8);
#define PG8_SA(b, h) (((b) * 2 + (h)) * HTB)
#define PG8_SB(b, h) ((4 + (b) * 2 + (h)) * HTB)
#define PG8_STAGE(bufoff, gbase, voff) do { _Pragma("unroll") for (int _i = 0; _i < 2; ++_i) \
        __builtin_amdgcn_global_load_lds((const unsigned*)((const char*)(gbase) + (voff)[_i]), (LAS unsigned*)(lds + (bufoff) + ldsw + _i * 8192), 16, 0, 0); } while (0)
#define PG8_LDA(dst, b, h) do { _Pragma("unroll") for (int m = 0; m < 4; ++m) _Pragma("unroll") for (int k = 0; k < 2; ++k) dst[m][k] = *(const LAS bf16x8*)(lds + PG8_SA(b, h) + aoff + m * 2048 + k * 1024); } while (0)
#define PG8_LDB(dst, b, h) do { _Pragma("unroll") for (int n = 0; n < 2; ++n) _Pragma("unroll") for (int k = 0; k < 2; ++k) dst[n][k] = *(const LAS bf16x8*)(lds + PG8_SB(b, h) + boff + n * 2048 + k * 1024); } while (0)
#define PG8_MMA(ai, bj, At, Bt) do { __builtin_amdgcn_s_setprio(1); _Pragma("unroll") for (int m = 0; m < 4; ++m) _Pragma("unroll") for (int n = 0; n < 2; ++n) _Pragma("unroll") for (int k = 0; k < 2; ++k) \
        acc[ai][bj][m][n] = __builtin_amdgcn_mfma_f32_16x16x32_bf16(Bt[n][k], At[m][k], acc[ai][bj][m][n], 0, 0, 0); __builtin_amdgcn_s_setprio(0); } while (0)
#define PG8_WAIT_V(n) asm volatile("s_waitcnt vmcnt(" #n ")" ::: "memory")
#define PG8_WAIT_L(n) asm volatile("s_waitcnt lgkmcnt(" #n ")" ::: "memory")
#define PG8_BAR __builtin_amdgcn_s_barrier()
#define PG8_SCHED __builtin_amdgcn_sched_barrier(0)
    Unit cur, nxt; int ui = 0;
    if (!S.next(0, cur)) return;
    unsigned cv[2][2], nv[2][2];
    LAS unsigned short* gtab = (LAS unsigned short*)(lds + STAGE_BYTES);
    int gR[2], gC2[2];
    if constexpr (GATHER) {
#pragma unroll
        for (int i = 0; i < 2; ++i) { int R, C; stage_rc(tid * 16 + i * 8192, R, C); gR[i] = R; gC2[i] = C * 2; }
        { Unit u; for (int i = 0; i < GATHER_MAX_UNITS && S.next(i, u); ++i) if (tid < 256) gtab[i * 256 + tid] = ridx[u.pm * 256 + tid]; }
        __syncthreads();
#pragma unroll
        for (int h = 0; h < 2; ++h)
#pragma unroll
            for (int i = 0; i < 2; ++i) cv[h][i] = (unsigned)gtab[h * 128 + gR[i]] * (unsigned)(K * 2) + (unsigned)gC2[i];
    }
    const bool gdg = DIAG_SEL && g.diag != nullptr && wid == DIAG_WAVE;
    unsigned long long g0 = 0, gep = 0, gc0 = 0;
    if (gdg) { g0 = __builtin_amdgcn_s_memrealtime(); gc0 = __builtin_amdgcn_s_memtime(); }
    f32x4 acc[2][2][4][2];
#pragma unroll
    for (int a = 0; a < 2; ++a)
#pragma unroll
        for (int b = 0; b < 2; ++b)
#pragma unroll
            for (int m = 0; m < 4; ++m)
#pragma unroll
                for (int n = 0; n < 2; ++n) acc[a][b][m][n] = (f32x4){0.f, 0.f, 0.f, 0.f};
    bf16x8 At[4][2], B0[2][2], B1[2][2];
#define PG8_STAGE_A(bufoff, p, h) do { if constexpr (GATHER) { PG8_STAGE(bufoff, p, cv[h]); } else { PG8_STAGE(bufoff, (p) + (h) * hstep, voffA); } } while (0)
    const char* cA = (const char*)g.A + (GATHER ? (size_t)0 : (size_t)cur.pm * tstep) + (size_t)cur.kt0 * kstep; const char* cB = (const char*)g.Bt + (size_t)cur.pb * tstep + (size_t)cur.kt0 * kstep;
    PG8_STAGE(PG8_SB(0, 0), cB, voffB); PG8_STAGE(PG8_SB(0, 1), cB + hstep, voffB); PG8_STAGE_A(PG8_SA(0, 0), cA, 0); PG8_STAGE_A(PG8_SA(0, 1), cA, 1);
    if (wr == 1) PG8_BAR;
    PG8_WAIT_V(2); PG8_BAR;
    PG8_STAGE(PG8_SB(1, 0), cB + kstep, voffB); PG8_STAGE_A(PG8_SA(1, 0), cA + kstep, 0); PG8_STAGE(PG8_SB(1, 1), cB + hstep + kstep, voffB);
    PG8_WAIT_V(6); PG8_BAR;
    for (;;) {
        const bool has_next = S.next(ui + 1, nxt);
        const char* nA = has_next ? (const char*)g.A + (GATHER ? (size_t)0 : (size_t)nxt.pm * tstep) + (size_t)nxt.kt0 * kstep : cA; const char* nB = has_next ? (const char*)g.Bt + (size_t)nxt.pb * tstep + (size_t)nxt.kt0 * kstep : cB;
        if constexpr (GATHER) {
#pragma unroll
            for (int h = 0; h < 2; ++h)
#pragma unroll
                for (int i = 0; i < 2; ++i) nv[h][i] = has_next ? (unsigned)gtab[(ui + 1) * 256 + h * 128 + gR[i]] * (unsigned)(K * 2) + (unsigned)gC2[i] : cv[h][i];
        }
        const int nt = cur.nkt;
        for (int t = 0; t < nt; t += 2) {
            const bool last = (t == nt - 2);
            const char* a1 = cA + (size_t)(t + 1) * kstep;
            const char* a2 = last ? nA : cA + (size_t)(t + 2) * kstep; const char* b2 = last ? nB : cB + (size_t)(t + 2) * kstep;
            const char* a3 = a2 + kstep; const char* b3 = b2 + kstep;
            PG8_LDB(B0, 0, 0); PG8_LDB(B1, 0, 1); PG8_SCHED; PG8_LDA(At, 0, 0); PG8_STAGE_A(PG8_SA(1, 1), a1, 1);
            if constexpr (GATHER) { if (last) {
#pragma unroll
                for (int h = 0; h < 2; ++h)
#pragma unroll
                    for (int i = 0; i < 2; ++i) cv[h][i] = nv[h][i]; } }
            PG8_WAIT_V(8); PG8_WAIT_L(0); PG8_BAR; PG8_MMA(0, 0, At, B0); PG8_MMA(0, 1, At, B1); PG8_BAR; PG8_SCHED;
            PG8_LDA(At, 0, 1); PG8_STAGE(PG8_SB(0, 0), b2, voffB); PG8_STAGE(PG8_SB(0, 1), b2 + hstep, voffB); PG8_STAGE_A(PG8_SA(0, 0), a2, 0);
            PG8_WAIT_V(8); PG8_WAIT_L(0); PG8_BAR; PG8_MMA(1, 0, At, B0); PG8_MMA(1, 1, At, B1); PG8_BAR; PG8_SCHED;
            PG8_LDB(B0, 1, 0); PG8_LDB(B1, 1, 1); PG8_SCHED; PG8_LDA(At, 1, 0); PG8_STAGE_A(PG8_SA(0, 1), a2, 1);
            PG8_WAIT_V(8); PG8_WAIT_L(0); PG8_BAR; PG8_MMA(0, 0, At, B0); PG8_MMA(0, 1, At, B1); PG8_BAR; PG8_SCHED;
            PG8_LDA(At, 1, 1); PG8_STAGE(PG8_SB(1, 0), b3, voffB); PG8_STAGE(PG8_SB(1, 1), b3 + hstep, voffB); PG8_STAGE_A(PG8_SA(1, 0), a3, 0);
            PG8_WAIT_V(8); PG8_WAIT_L(0); PG8_BAR; PG8_MMA(1, 0, At, B0); PG8_MMA(1, 1, At, B1); PG8_BAR; PG8_SCHED;
        }
        if (wr == 0) PG8_BAR;
        unsigned long long ge0 = 0; if (gdg) ge0 = __builtin_amdgcn_s_memrealtime();
        E(acc, cur, wr, wc, fr, fq);
        if (gdg) { asm volatile("" ::: "memory"); gep += __builtin_amdgcn_s_memrealtime() - ge0; }
        if (!has_next) break;
#pragma unroll
        for (int a = 0; a < 2; ++a)
#pragma unroll
            for (int b = 0; b < 2; ++b)
#pragma unroll
                for (int m = 0; m < 4; ++m)
#pragma unroll
                    for (int n = 0; n < 2; ++n) acc[a][b][m][n] = (f32x4){0.f, 0.f, 0.f, 0.f};
        cur = nxt; cA = nA; cB = nB; ++ui;
        if (wr == 1) PG8_BAR;
    }
    PG8_WAIT_V(0);
    PG8_BAR;
    if (gdg && lane == 0) { const unsigned long long g1 = __builtin_amdgcn_s_memrealtime(), gc1 = __builtin_amdgcn_s_memtime(); g.diag[8] = (unsigned)(g1 - g0); g.diag[9] = (unsigned)gep; g.diag[10] = (unsigned)((gc1 - gc0) >> 8); g.diag[11] = (unsigned)(ui + 1) * 500u; }
#undef PG8_SA
#undef PG8_SB
#undef PG8_STAGE
#undef PG8_STAGE_A
#undef PG8_LDA
#undef PG8_LDB
#undef PG8_MMA
#undef PG8_WAIT_V
#undef PG8_WAIT_L
#undef PG8_BAR
#undef PG8_SCHED
}
}

namespace att {
typedef LAS const char* lcptr;
typedef short v4i16_t __attribute__((ext_vector_type(4)));
constexpr int KBUF = 0, KS = 16384, NKS = 4, VBUF = 65536, VS = 16384, NVS = 3, WSF = 114688, XCH = 32768;
constexpr float THR = 8.0f;
__device__ __forceinline__ int crow(int r, int hi) { return (r & 3) + 8 * (r >> 2) + 4 * hi; }
__device__ __forceinline__ s16x4 vtr(lcptr p) { return __builtin_bit_cast(s16x4, __builtin_amdgcn_ds_read_tr16_b64_v4i16((LAS v4i16_t*)p)); }

struct UnitD {
    int qrow0;
    int qcol, kcol, vcol;
    int n1, base1, n2, base2;
    int kp0;
    int qp0;
    int masked;
    float sink2;
    int use_sink;
    int ocol;
    unsigned* diag;
};

__device__ __forceinline__ void glds16(const void* gsrc, unsigned lds_dst) { unsigned keep;
    asm volatile("s_mov_b32 %0, m0\n\ts_mov_b32 m0, %2\n\ts_nop 0\n\tglobal_load_lds_dwordx4 %1, off\n\ts_mov_b32 m0, %0" : "=&s"(keep) : "v"(gsrc), "s"(lds_dst) : "memory"); }
template <bool TB>
__device__ __forceinline__ void dma_k(const bf16_t* QKV, int NQ, int rowbase, int kcol, unsigned kbuf, int wid, int lane) {
#pragma unroll
    for (int i = 0; i < (TB ? 2 : 1); ++i) { const int pc = wid + 8 * i, head = pc >> 3, ch = pc & 7;
        const bf16_t* src = QKV + (size_t)(rowbase + lane) * NQ + kcol + head * 64 + ch * 8;
        glds16(src, (unsigned)__builtin_amdgcn_readfirstlane(kbuf + head * 8192 + ch * 1024)); }
}
template <bool TB>
__device__ __forceinline__ void dma_v(const bf16_t* QKV, int NQ, int rowbase, int vcol, unsigned vbuf, int wid, int lane) {
#pragma unroll
    for (int i = 0; i < (TB ? 2 : 1); ++i) { const int pv = wid + 8 * i, dblk = pv >> 2, rg = pv & 3;
        const bf16_t* src = QKV + (size_t)(rowbase + 16 * rg + (lane >> 2)) * NQ + vcol + dblk * 32 + (lane & 3) * 8;
        glds16(src, (unsigned)__builtin_amdgcn_readfirstlane(vbuf + pv * 1024)); }
}

template <bool TB>
__device__ __forceinline__ void attn_unit(LAS unsigned char* lds, const bf16_t* QKV, int NQ, bf16_t* O, const UnitD& U, float lam, float post_scale, const float* subln) {
    constexpr int NDB = TB ? 4 : 2;
    const int tid = fresh_tid(), lane = tid & 63, r32 = lane & 31, hi = lane >> 5; const int wid = __builtin_amdgcn_readfirstlane(tid >> 6);
    const int sub = wid >> 2, w4 = wid & 3;
    LAS float* wsf = (LAS float*)(lds + WSF) + wid * 64;
    const int NT = U.n1 + U.n2;
#define ATT_ROWBASE(tt) ((tt) < U.n1 ? U.base1 + 64 * (tt) : U.base2 + 64 * ((tt) - U.n1))
    const unsigned lds0 = (unsigned)(uintptr_t)lds;
    const bool dg = false;
    unsigned long long dt0 = 0, dt1 = 0, dt2 = 0, dwait = 0, dA = 0, dB = 0, dsa = 0;
    if (dg) dt0 = __builtin_amdgcn_s_memrealtime();
    dma_k<TB>(QKV, NQ, U.base1, U.kcol, lds0 + KBUF, wid, lane);
    dma_v<TB>(QKV, NQ, U.base1, U.vcol, lds0 + VBUF, wid, lane);
    if (NT > 1) { dma_k<TB>(QKV, NQ, ATT_ROWBASE(1), U.kcol, lds0 + KBUF + KS, wid, lane); dma_v<TB>(QKV, NQ, ATT_ROWBASE(1), U.vcol, lds0 + VBUF + VS, wid, lane); }
    if (NT > 2) dma_k<TB>(QKV, NQ, ATT_ROWBASE(2), U.kcol, lds0 + KBUF + 2 * KS, wid, lane);
    bf16x8 qr[4];
    { const bf16_t* qp = QKV + (size_t)(U.qrow0 + w4 * 32 + r32) * NQ + U.qcol + hi * 8;
#pragma unroll
      for (int d0 = 0; d0 < 4; ++d0) qr[d0] = *(const bf16x8*)(qp + d0 * 16); }
    f32x16 o[NDB];
#pragma unroll
    for (int d = 0; d < NDB; ++d) o[d] = f32x16{};
    f32x16 negm = f32x16{}; float mhat = 0.f, l_reg = 0.f;
    const int qpos = U.qp0 + r32;
    VM_WAIT(); __builtin_amdgcn_s_barrier(); asm volatile("" ::: "memory");
    asm volatile("" : "+v"(qr[0]), "+v"(qr[1]), "+v"(qr[2]), "+v"(qr[3]));
    int ks = 0, vs = 0;
#define ATT_SBAR() __builtin_amdgcn_sched_barrier(0)
#define ATT_KLOAD(slot) do { const lcptr kb_ = (lcptr)(lds + KBUF + (slot) * KS + (TB ? sub * 8192 : 0)) + hi * 1024 + r32 * 16; \
        _Pragma("unroll") for (int i_ = 0; i_ < 8; ++i_) kf[i_] = *(const LAS bf16x8*)(kb_ + (i_ >> 1) * 2048 + (i_ & 1) * 512); } while (0)
#define ATT_VLOAD(LO, HI, d) do { _Pragma("unroll") for (int k4 = 0; k4 < 4; ++k4) { LO[k4] = vtr(vp + (d) * 4096 + k4 * 1024); HI[k4] = vtr(vp + (d) * 4096 + k4 * 1024 + 512); } } while (0)
#define ATT_VMMA(LO, HI, d) do { _Pragma("unroll") for (int k4 = 0; k4 < 4; ++k4) o[d] = __builtin_amdgcn_mfma_f32_32x32x16_bf16(__builtin_bit_cast(bf16x8, pw[k4]), \
        ((bf16x8){LO[k4][0], LO[k4][1], LO[k4][2], LO[k4][3], HI[k4][0], HI[k4][1], HI[k4][2], HI[k4][3]}), o[d], 0, 0, 0); } while (0)
    bf16x8 kf[8];
    f32x16 p0, p1; u32x4 pw[4];
#define ATT_QK() do { p0 = __builtin_amdgcn_mfma_f32_32x32x16_bf16(kf[0], qr[0], negm, 0, 0, 0); p1 = __builtin_amdgcn_mfma_f32_32x32x16_bf16(kf[1], qr[0], negm, 0, 0, 0); \
        _Pragma("unroll") for (int d0 = 1; d0 < 4; ++d0) { p0 = __builtin_amdgcn_mfma_f32_32x32x16_bf16(kf[2 * d0], qr[d0], p0, 0, 0, 0); p1 = __builtin_amdgcn_mfma_f32_32x32x16_bf16(kf[2 * d0 + 1], qr[d0], p1, 0, 0, 0); } } while (0)
#define ATT_SOFTMAX(tt) do { \
        if (!TB) { if (U.masked && (tt) >= U.n1) { const int dl0 = U.kp0 + 64 * ((tt) - U.n1) + 4 * hi - qpos; \
            _Pragma("unroll") for (int r = 0; r < 16; ++r) { const int dlt = dl0 + (r & 3) + 8 * (r >> 2); \
                if (dlt > 128 || dlt < -128) p0[r] = -1e30f; if (dlt + 32 > 128 || dlt + 32 < -128) p1[r] = -1e30f; } } } \
        float rm; { float a = __builtin_fmaxf(__builtin_fmaxf(p0[0], p0[1]), p1[0]), b = __builtin_fmaxf(__builtin_fmaxf(p0[2], p0[3]), p1[1]); a = __builtin_fmaxf(__builtin_fmaxf(a, p1[2]), p1[3]); \
          _Pragma("unroll") for (int r = 4; r < 16; r += 4) { a = __builtin_fmaxf(__builtin_fmaxf(a, p0[r]), p0[r + 1]); b = __builtin_fmaxf(__builtin_fmaxf(b, p0[r + 2]), p0[r + 3]); a = __builtin_fmaxf(__builtin_fmaxf(a, p1[r]), p1[r + 1]); b = __builtin_fmaxf(__builtin_fmaxf(b, p1[r + 2]), p1[r + 3]); } \
          rm = __builtin_fmaxf(a, b); auto rr = __builtin_amdgcn_permlane32_swap(__float_as_uint(rm), __float_as_uint(rm), false, false); rm = __builtin_fmaxf(__uint_as_float(rr[0]), __uint_as_float(rr[1])); } \
        if ((tt) == 0) { mhat = rm; _Pragma("unroll") for (int r = 0; r < 16; ++r) { p0[r] -= rm; p1[r] -= rm; negm[r] = -mhat; } } \
        else if (__any(rm > THR)) { const float dl = __builtin_fmaxf(rm, 0.f); mhat += dl; \
            _Pragma("unroll") for (int r = 0; r < 16; ++r) { p0[r] -= dl; p1[r] -= dl; negm[r] = -mhat; } \
            const float f = __builtin_amdgcn_exp2f(-dl); l_reg *= f; if (hi == 0) wsf[r32] = f; LDS_WAIT(); \
            _Pragma("unroll") for (int r = 0; r < 16; ++r) { const float fr_ = wsf[crow(r, hi)]; _Pragma("unroll") for (int d = 0; d < NDB; ++d) o[d][r] *= fr_; } } \
        float sacc = 0.f; \
        _Pragma("unroll") for (int r = 0; r < 16; ++r) { p0[r] = __builtin_amdgcn_exp2f(p0[r]); p1[r] = __builtin_amdgcn_exp2f(p1[r]); sacc += p0[r] + p1[r]; } \
        l_reg += sacc; \
        _Pragma("unroll") for (int s = 0; s < 2; ++s) { pw[s] = (u32x4){cvt_pk_bf16(p0[8 * s], p0[8 * s + 1]), cvt_pk_bf16(p0[8 * s + 2], p0[8 * s + 3]), cvt_pk_bf16(p0[8 * s + 4], p0[8 * s + 5]), cvt_pk_bf16(p0[8 * s + 6], p0[8 * s + 7])}; \
            pw[2 + s] = (u32x4){cvt_pk_bf16(p1[8 * s], p1[8 * s + 1]), cvt_pk_bf16(p1[8 * s + 2], p1[8 * s + 3]), cvt_pk_bf16(p1[8 * s + 4], p1[8 * s + 5]), cvt_pk_bf16(p1[8 * s + 6], p1[8 * s + 7])}; } } while (0)
    ATT_KLOAD(0);
    ATT_QK();
    ATT_SOFTMAX(0);
    if (sub == 1) __builtin_amdgcn_s_setprio(1);
    for (int t = 0; t < NT; ++t) {
        if (t + 2 < NT) { if (TB) asm volatile("s_waitcnt vmcnt(4)" ::: "memory"); else asm volatile("s_waitcnt vmcnt(2)" ::: "memory"); } else VM_WAIT();
        __builtin_amdgcn_s_barrier(); asm volatile("" ::: "memory");
        if (t + 3 < NT) { const int k3 = (ks + 3) & 3; dma_k<TB>(QKV, NQ, ATT_ROWBASE(t + 3), U.kcol, lds0 + KBUF + k3 * KS, wid, lane); }
        if (t + 2 < NT) { int v2 = vs + 2; v2 = v2 >= 3 ? v2 - 3 : v2; dma_v<TB>(QKV, NQ, ATT_ROWBASE(t + 2), U.vcol, lds0 + VBUF + v2 * VS, wid, lane); }
        const lcptr vp = (lcptr)(lds + VBUF + vs * VS) + ((lane >> 4) & 1) * 32 + (lane & 3) * 8 + (4 * hi + ((lane & 15) >> 2)) * 64;
        s16x4 va_lo[4], va_hi[4], vb_lo[4], vb_hi[4];
        const bool more = t + 1 < NT;
        ATT_SBAR();
        ATT_VLOAD(va_lo, va_hi, 0);
        ATT_VLOAD(vb_lo, vb_hi, 1);
        ATT_SBAR();
        ATT_VMMA(va_lo, va_hi, 0);
        if (TB) { ATT_SBAR(); ATT_VLOAD(va_lo, va_hi, NDB - 2); }
        else { ATT_SBAR(); if (more) { const int k1 = (ks + 1) & 3; ATT_KLOAD(k1); } }
        ATT_SBAR();
        ATT_VMMA(vb_lo, vb_hi, 1);
        if (TB) { ATT_SBAR(); ATT_VLOAD(vb_lo, vb_hi, NDB - 1); ATT_SBAR(); ATT_VMMA(va_lo, va_hi, NDB - 2); ATT_SBAR(); if (more) { const int k1 = (ks + 1) & 3; ATT_KLOAD(k1); } ATT_SBAR(); ATT_VMMA(vb_lo, vb_hi, NDB - 1); }
        ATT_SBAR();
        if (more) {
            ATT_QK();
            ATT_SBAR();
            ATT_SOFTMAX(t + 1);
        }
        ks = (ks + 1) & 3; vs = vs == 2 ? 0 : vs + 1;
    }
    __builtin_amdgcn_s_setprio(0);
#undef ATT_QK
#undef ATT_SOFTMAX
#undef ATT_SBAR
#undef ATT_KLOAD
#undef ATT_VLOAD
#undef ATT_VMMA
#undef ATT_SEAM
#undef ATT_ROWBASE
    { auto rr = __builtin_amdgcn_permlane32_swap(__float_as_uint(l_reg), __float_as_uint(l_reg), false, false); l_reg = __uint_as_float(rr[0]) + __uint_as_float(rr[1]); }
    if (!TB) { if (U.use_sink) l_reg += __builtin_amdgcn_exp2f(U.sink2 - mhat); }
    if (hi == 0) wsf[32 + r32] = l_reg;
    LDS_WAIT();
    float rli[16];
#pragma unroll
    for (int r = 0; r < 16; ++r) rli[r] = 1.0f / wsf[32 + crow(r, hi)];
    const int orow0 = U.qrow0 + w4 * 32;
    if (!TB) {
        __builtin_amdgcn_s_barrier(); asm volatile("" ::: "memory");
        LAS unsigned short* stg = (LAS unsigned short*)(lds + (sub == 0 ? KBUF + 3 * KS : VBUF + 2 * VS)) + w4 * 2048;
#pragma unroll
        for (int r = 0; r < 16; ++r) {
#pragma unroll
            for (int d = 0; d < NDB; ++d) stg[crow(r, hi) * 64 + d * 32 + r32] = (unsigned short)(cvt_pk_bf16(o[d][r] * rli[r], 0.f) & 0xffffu); }
        LDS_WAIT();
#pragma unroll
        for (int i = 0; i < 4; ++i) { const int row = i * 8 + (lane >> 3), ch = lane & 7; const u32x4 v = *(const LAS u32x4*)(stg + row * 64 + ch * 8);
            *(u32x4*)(O + (size_t)(orow0 + row) * D + U.ocol + ch * 8) = v; }
    } else {
        LAS float* X = (LAS float*)(lds + XCH) + (size_t)w4 * 2048 + lane;
#pragma unroll
        for (int rd = 0; rd < 2; ++rd) {
            if (sub == 1) {
#pragma unroll
                for (int d = 0; d < 2; ++d)
#pragma unroll
                    for (int r = 0; r < 16; ++r) X[(d * 16 + r) * 64] = o[2 * rd + d][r] * rli[r];
            }
            LDS_WAIT(); __builtin_amdgcn_s_barrier(); asm volatile("" ::: "memory");
            if (sub == 0) {
#pragma unroll
                for (int d = 0; d < 2; ++d)
#pragma unroll
                    for (int r = 0; r < 16; ++r) o[2 * rd + d][r] = o[2 * rd + d][r] * rli[r] - lam * X[(d * 16 + r) * 64];
            }
            LDS_WAIT(); __builtin_amdgcn_s_barrier(); asm volatile("" ::: "memory");
        }
        if (sub == 0) {
            float gam[NDB];
#pragma unroll
            for (int d = 0; d < NDB; ++d) gam[d] = subln[d * 32 + r32] * post_scale;
#pragma unroll
            for (int r = 0; r < 16; ++r) { float ss = 0.f;
#pragma unroll
                for (int d = 0; d < NDB; ++d) ss += o[d][r] * o[d][r];
#pragma unroll
                for (int off = 1; off < 32; off <<= 1) ss += __shfl_xor(ss, off);
                const float rs = 1.0f / sqrtf(ss * (1.0f / 128.0f) + RMS_EPS);
#pragma unroll
                for (int d = 0; d < NDB; ++d) o[d][r] *= rs * gam[d]; }
            LAS unsigned short* stg = (LAS unsigned short*)(lds + VBUF + 2 * VS) + w4 * 2048;
#pragma unroll
            for (int hf = 0; hf < 2; ++hf) {
#pragma unroll
                for (int r = 0; r < 16; ++r) {
#pragma unroll
                    for (int d = 0; d < 2; ++d) stg[crow(r, hi) * 64 + d * 32 + r32] = (unsigned short)(cvt_pk_bf16(o[2 * hf + d][r], 0.f) & 0xffffu); }
                LDS_WAIT();
#pragma unroll
                for (int i = 0; i < 4; ++i) { const int row = i * 8 + (lane >> 3), ch = lane & 7; const u32x4 v = *(const LAS u32x4*)(stg + row * 64 + ch * 8);
                    *(u32x4*)(O + (size_t)(orow0 + row) * D + U.ocol + hf * 64 + ch * 8) = v; }
                LDS_WAIT();
            }
        }
    }
}
}

#define XB_TMO      128
#define XB_XCNT(j)  (256  + 64 * (j))
#define XB_XSUB(j)  (1280 + 64 * (j))
#define XB_XGEN(j)  (2304 + 64 * (j))
#define XB_TOP      3328
#define XB_TOPGEN   3392
#define XCD_BAR_WORDS 3456
#define XB_SPIN_CAP (1u << 18)

__device__ __forceinline__ unsigned xb_ld(unsigned* p)              { return __hip_atomic_load(p, __ATOMIC_RELAXED, __HIP_MEMORY_SCOPE_AGENT); }
__device__ __forceinline__ unsigned xb_add(unsigned* p, unsigned v) { return __hip_atomic_fetch_add(p, v, __ATOMIC_RELAXED, __HIP_MEMORY_SCOPE_AGENT); }
__device__ __forceinline__ unsigned xb_xcc_id() { return (unsigned)__builtin_amdgcn_s_getreg((3 << 11) | 20) & 0xFu; }
#define XB_SPIN(cond, bar) do { unsigned _sp = 0; while (cond) { __builtin_amdgcn_s_sleep(1); \
    if ((++_sp & 255u) == 0u) { if (xb_ld(&(bar)[XB_TMO])) break; if (_sp > XB_SPIN_CAP) { atomicAdd(&(bar)[XB_TMO], 1u); break; } } } } while (0)

struct XcdBarrier { unsigned* bar; unsigned x; volatile LAS unsigned* st; };

__device__ __forceinline__ XcdBarrier xcd_barrier_post(unsigned* bar, volatile LAS unsigned* st) {
    XcdBarrier b; b.bar = bar; b.x = xb_xcc_id(); b.st = st;
    if (threadIdx.x == 0) (void)xb_add(&bar[XB_XCNT(b.x)], 1u);
    return b;
}
__device__ __forceinline__ void xcd_barrier_complete(unsigned* bar, unsigned x, unsigned& nloc, unsigned& nx) {
    const unsigned G = gridDim.x * gridDim.y * gridDim.z;
    unsigned sum, cnt, mine, sp = 0u;
    for (;;) {
        sum = 0u; cnt = 0u; mine = 0u;
#pragma unroll
        for (unsigned j = 0; j < 16; ++j) { const unsigned c = xb_ld(&bar[XB_XCNT(j)]); sum += c; cnt += (c > 0u) ? 1u : 0u; mine = (j == x) ? c : mine; }
        if (sum == G) break;
        __builtin_amdgcn_s_sleep(1);
        if ((++sp & 255u) == 0u) { if (xb_ld(&bar[XB_TMO])) break; if (sp > XB_SPIN_CAP) { atomicAdd(&bar[XB_TMO], 1u); break; } }
    }
    nloc = mine > 0u ? mine : 1u; nx = cnt > 0u ? cnt : 1u;
}
__device__ __forceinline__ void xcd_barrier(const XcdBarrier& b) {
    asm volatile("s_waitcnt vmcnt(0)" ::: "memory");
    __syncthreads();
    if (threadIdx.x == 0) {
        unsigned* bar = b.bar;
        __builtin_amdgcn_s_waitcnt(0);
        unsigned nloc = b.st[0], nx = b.st[1];
        if (nloc == 0u) { xcd_barrier_complete(bar, b.x, nloc, nx); b.st[0] = nloc; b.st[1] = nx; }
        const unsigned old = xb_add(&bar[XB_XSUB(b.x)], 1u);
        const unsigned gen = old / nloc;
        if (old + 1u == (gen + 1u) * nloc) {
            __builtin_amdgcn_fence(__ATOMIC_RELEASE, "agent");
            asm volatile("s_waitcnt vmcnt(0)" ::: "memory");
            (void)xb_add(&bar[XB_TOP], 1u);
        }
        const unsigned target = (gen + 1u) * nx;
        XB_SPIN(xb_ld(&bar[XB_TOP]) < target, bar);
        __builtin_amdgcn_fence(__ATOMIC_ACQUIRE, "agent");
        asm volatile("s_waitcnt vmcnt(0)" ::: "memory");
    }
    __syncthreads();
}

struct Args {
    const float* x; const float* c; const float* ctx; const float* c_ctx; const float* w_mod; const float* b_mod; const float* ln_g; const float* ln_b;
    const float* a_w_qkv; const float* a_sink; const float* a_w_o; const float* b_w_qkv; const float* lq1; const float* lk1; const float* lq2; const float* lk2;
    const float* subln; const float* b_w_o; const float* ff_g; const float* ff_u; const float* ff_d; const float* moe_r; const float* moe_g; const float* moe_u; const float* moe_d;
    float* out; unsigned char* ws; int ph_lo, ph_hi;
};

__device__ __forceinline__ void transpose_item(const float* W, int K, int N, bf16_t* WT, int drow0, LAS float* scr, int k0, int n0, int lane) {
#pragma unroll 8
    for (int i = 0; i < 32; ++i) { const int kk = 2 * i + (lane >> 5); scr[kk * 33 + (lane & 31)] = W[(size_t)(k0 + kk) * N + n0 + (lane & 31)]; }
    LDS_WAIT(); asm volatile("" ::: "memory");
    const int c = lane & 7;
#pragma unroll
    for (int j = 0; j < 4; ++j) { const int n = (lane >> 3) + 8 * j; const LAS float* s = scr + (8 * c) * 33 + n;
        u32x4 o; o.x = cvt_pk_bf16(s[0 * 33], s[1 * 33]); o.y = cvt_pk_bf16(s[2 * 33], s[3 * 33]); o.z = cvt_pk_bf16(s[4 * 33], s[5 * 33]); o.w = cvt_pk_bf16(s[6 * 33], s[7 * 33]);
        *(u32x4*)(WT + (size_t)(drow0 + n) * K + k0 + 8 * c) = o; }
    LDS_WAIT(); asm volatile("" ::: "memory");
}
__device__ __forceinline__ void convert_mats(const float* src, int K, int N, int nmat, bf16_t* dst, int mode, LAS float* scr, int gw, int NGW, int& rot, int lane) {
    const int nnb = N / 32, ipm = (K / 64) * nnb, total = nmat * ipm;
    const size_t dstride = (size_t)(mode ? 2 * N : N) * K;
    int start = gw - rot; if (start < 0) start += NGW;
    for (int it = start; it < total; it += NGW) {
        const int mat = it / ipm, r = it - mat * ipm, kb = r / nnb, nb = r - kb * nnb, n0 = nb * 32;
        const int drow0 = mode == 0 ? n0 : ((n0 >> 7) * 256 + (n0 & 127) + (mode == 2 ? 128 : 0));
        transpose_item(src + (size_t)mat * K * N, K, N, dst + (size_t)mat * dstride, drow0, scr, kb * 64, n0, lane);
    }
    rot = (rot + total) % NGW;
}

struct RowP {
    const bf16_t* xin_b;
    bf16_t* xout_b;
    float* xout_f;
    const bf16_t* F;
    const bf16_t* Fp;
    const float* mod_gate; const float* lg; const float* lb;
    const float* mod_sc; const float* mod_sh;
    bf16_t* H;
    const unsigned* tok;
    int two;
    const float* wr;
    unsigned* cnt;
    unsigned* tokw;
};

template <int CTRL> __device__ __forceinline__ float dpp_xadd(float v) { return v + __int_as_float(__builtin_amdgcn_update_dpp(0, __float_as_int(v), CTRL, 0xF, 0xF, true)); }
__device__ __forceinline__ float wave_allsum(float v) {
    v = dpp_xadd<0xB1>(v); v = dpp_xadd<0x4E>(v); v = dpp_xadd<0x141>(v); v = dpp_xadd<0x140>(v);
    { auto r = __builtin_amdgcn_permlane16_swap(__float_as_uint(v), __float_as_uint(v), false, false); v = __uint_as_float(r[0]) + __uint_as_float(r[1]); }
    { auto r = __builtin_amdgcn_permlane32_swap(__float_as_uint(v), __float_as_uint(v), false, false); v = __uint_as_float(r[0]) + __uint_as_float(r[1]); }
    return v;
}
__device__ __forceinline__ float router_reduce(const float (&lg)[8], int lane) {
    float s[4], t[2];
#pragma unroll
    for (int k = 0; k < 4; ++k) { auto r = __builtin_amdgcn_permlane32_swap(__float_as_uint(lg[k]), __float_as_uint(lg[k + 4]), false, false); s[k] = __uint_as_float(r[0]) + __uint_as_float(r[1]); }
#pragma unroll
    for (int k = 0; k < 2; ++k) { auto r = __builtin_amdgcn_permlane16_swap(__float_as_uint(s[k]), __float_as_uint(s[k + 2]), false, false); t[k] = __uint_as_float(r[0]) + __uint_as_float(r[1]); }
    const float snd = (lane & 1) ? t[0] : t[1], kp = (lane & 1) ? t[1] : t[0];
    float u = kp + __int_as_float(__builtin_amdgcn_update_dpp(0, __float_as_int(snd), 0xB1, 0xF, 0xF, true));
    u = dpp_xadd<0x4E>(u); u = dpp_xadd<0x124>(u); u = dpp_xadd<0x128>(u);
    return u;
}
template <bool TWO, bool OUTF>
__device__ __forceinline__ void row_phase(const RowP& P, int row_lo, int nrows, LAS unsigned char* lds, int tid, int lane, int wave, int half_rows) {
    const int rpb = nrows / GRID, brow0 = row_lo + (int)blockIdx.x, nj = rpb >> 3;
#define CB(jj) (8 * lane + 512 * ((jj) >> 1) + 4 * ((jj) & 1))
#define UNPK_LO(w4) ((f32x4){bf_lo((w4).x), bf_hi((w4).x), bf_lo((w4).y), bf_hi((w4).y)})
#define UNPK_HI(w4) ((f32x4){bf_lo((w4).z), bf_hi((w4).z), bf_lo((w4).w), bf_hi((w4).w)})
    LAS f32x4* wrl = (LAS f32x4*)lds;
    LAS int* ebuf = (LAS int*)(lds + 32768);
    __syncthreads();
    if (P.wr) {
        for (int idx = tid; idx < 2048; idx += 512) { const int l = idx & 63, hh = (idx >> 6) & 1, e4 = (idx >> 7) & 3, j = idx >> 9; const int d = 8 * l + 512 * (j >> 1) + 4 * (j & 1) + e4;
            wrl[idx] = *(const f32x4*)(P.wr + (size_t)d * 8 + hh * 4); }
    }
    LAS f32x4* lgl = (LAS f32x4*)(lds + 40960);
    LAS f32x4* lbl = (LAS f32x4*)(lds + 45056);
    if (tid < 256) { const int l = tid & 63, j = tid >> 6; const int c = 8 * l + 512 * (j >> 1) + 4 * (j & 1); lgl[tid] = *(const f32x4*)(P.lg + c); lbl[tid] = *(const f32x4*)(P.lb + c); }
    __syncthreads();
    const bool dense18 = nj == 18;
#define JOF(i_) (dense18 ? ((i_) < 16 ? 16 * wave + (i_) : 128 + 2 * wave + ((i_) - 16)) : wave * nj + (i_))
    u32x4 a_x[2], a_fa[2], a_fb[2], b_x[2], b_fa[2], b_fb[2], pa[6], pb[6];
    int a_row, a_r1, a_r2, b_row, b_r1, b_r2; float a_w1, a_w2, b_w1, b_w2;
    f32x4 gv[4], scv[4], shv[4]; int m_cur = -1;
#define RP_FILL(S, i_) { \
        const int row_ = brow0 + GRID * JOF(i_); S##_row = row_; S##_r1 = row_; S##_r2 = row_; S##_w1 = 1.f; S##_w2 = 0.f; \
        if (TWO) { S##_r1 = (int)P.tok[TOK_SLOT + 2 * row_]; S##_r2 = (int)P.tok[TOK_SLOT + 2 * row_ + 1]; S##_w1 = __uint_as_float(P.tok[TOK_W + 2 * row_]); S##_w2 = __uint_as_float(P.tok[TOK_W + 2 * row_ + 1]); } \
        _Pragma("unroll") for (int p = 0; p < 2; ++p) { const int c8 = 8 * lane + 512 * p; \
            S##_x[p] = *(const u32x4*)(P.xin_b + (size_t)row_ * D + c8); S##_fa[p] = *(const u32x4*)(P.F + (size_t)S##_r1 * D + c8); \
            if (TWO) S##_fb[p] = *(const u32x4*)(P.F + (size_t)S##_r2 * D + c8); } }
#define RP_PART(S) { \
        if (S##_r1 >= SPLIT_ROW0) { _Pragma("unroll") for (int pp = 0; pp < 3; ++pp) _Pragma("unroll") for (int p = 0; p < 2; ++p) pa[2 * pp + p] = *(const u32x4*)(P.Fp + (size_t)pp * PART_STRIDE + (size_t)S##_r1 * D + 8 * lane + 512 * p); } \
        if (TWO && S##_r2 >= SPLIT_ROW0) { _Pragma("unroll") for (int pp = 0; pp < 3; ++pp) _Pragma("unroll") for (int p = 0; p < 2; ++p) pb[2 * pp + p] = *(const u32x4*)(P.Fp + (size_t)pp * PART_STRIDE + (size_t)S##_r2 * D + 8 * lane + 512 * p); } }
    u32x4 ox[2], oh[2]; f32x4 of[4]; int o_row = 0;
#define RP_STORE() { _Pragma("unroll") for (int p = 0; p < 2; ++p) { const int c8 = 8 * lane + 512 * p; \
            if (OUTF) { *(f32x4*)(P.xout_f + (size_t)o_row * D + c8) = of[2 * p]; *(f32x4*)(P.xout_f + (size_t)o_row * D + c8 + 4) = of[2 * p + 1]; } \
            else { *(u32x4*)(P.xout_b + (size_t)o_row * D + c8) = ox[p]; *(u32x4*)(P.H + (size_t)o_row * D + c8) = oh[p]; } } }
#define RP_BODY(S, T, i_) { \
        const int c_row = S##_row; const int c_mrow = c_row < ML ? (c_row >> 11) : 16; \
        if (c_mrow != m_cur) { m_cur = c_mrow; \
            _Pragma("unroll") for (int j = 0; j < 4; ++j) { gv[j] = *(const f32x4*)(P.mod_gate + (size_t)c_mrow * NMOD + CB(j)); \
                if (!OUTF) { scv[j] = *(const f32x4*)(P.mod_sc + (size_t)c_mrow * NMOD + CB(j)); shv[j] = *(const f32x4*)(P.mod_sh + (size_t)c_mrow * NMOD + CB(j)); } } } \
        f32x4 v[4]; \
        _Pragma("unroll") for (int p = 0; p < 2; ++p) { \
            v[2 * p] = UNPK_LO(S##_fa[p]) * S##_w1; v[2 * p + 1] = UNPK_HI(S##_fa[p]) * S##_w1; \
            if (TWO) { v[2 * p] += UNPK_LO(S##_fb[p]) * S##_w2; v[2 * p + 1] += UNPK_HI(S##_fb[p]) * S##_w2; } } \
        if (S##_r1 >= SPLIT_ROW0) { \
            _Pragma("unroll") for (int pp = 0; pp < 3; ++pp) _Pragma("unroll") for (int p = 0; p < 2; ++p) { v[2 * p] += UNPK_LO(pa[2 * pp + p]) * S##_w1; v[2 * p + 1] += UNPK_HI(pa[2 * pp + p]) * S##_w1; } } \
        if (TWO && S##_r2 >= SPLIT_ROW0) { \
            _Pragma("unroll") for (int pp = 0; pp < 3; ++pp) _Pragma("unroll") for (int p = 0; p < 2; ++p) { v[2 * p] += UNPK_LO(pb[2 * pp + p]) * S##_w2; v[2 * p + 1] += UNPK_HI(pb[2 * pp + p]) * S##_w2; } } \
        _Pragma("unroll") for (int j = 0; j < 4; ++j) { const f32x4 xj = (j & 1) ? UNPK_HI(S##_x[j >> 1]) : UNPK_LO(S##_x[j >> 1]); v[j] = xj * DN_ALPHA + (gv[j] + 1.0f) * v[j]; } \
        if ((i_) > 0) RP_STORE();                                    \
        { const int i2_ = (i_) + 2 < nj ? (i_) + 2 : nj - 1; RP_FILL(S, i2_); }     \
        if ((i_) + 1 < nj) RP_PART(T); \
        float s = 0.f; \
        _Pragma("unroll") for (int j = 0; j < 4; ++j) s += (v[j][0] + v[j][1]) + (v[j][2] + v[j][3]); \
        const float mean = wave_allsum(s) * (1.f / D); \
        float s2 = 0.f; \
        _Pragma("unroll") for (int j = 0; j < 4; ++j) { v[j] = v[j] - mean; s2 += (v[j][0] * v[j][0] + v[j][1] * v[j][1]) + (v[j][2] * v[j][2] + v[j][3] * v[j][3]); } \
        const float rstd = 1.f / sqrtf(wave_allsum(s2) * (1.f / D) + LN_EPS); \
        o_row = c_row; \
        _Pragma("unroll") for (int p = 0; p < 2; ++p) { \
            const f32x4 xa = v[2 * p] * rstd * lgl[(2 * p) * 64 + lane] + lbl[(2 * p) * 64 + lane], xb = v[2 * p + 1] * rstd * lgl[(2 * p + 1) * 64 + lane] + lbl[(2 * p + 1) * 64 + lane]; \
            if (OUTF) { of[2 * p] = xa; of[2 * p + 1] = xb; } \
            else { \
                ox[p].x = cvt_pk_bf16(xa[0], xa[1]); ox[p].y = cvt_pk_bf16(xa[2], xa[3]); ox[p].z = cvt_pk_bf16(xb[0], xb[1]); ox[p].w = cvt_pk_bf16(xb[2], xb[3]); \
                const f32x4 ha = xa * (scv[2 * p] + 1.0f) + shv[2 * p], hb = xb * (scv[2 * p + 1] + 1.0f) + shv[2 * p + 1]; \
                oh[p].x = cvt_pk_bf16(ha[0], ha[1]); oh[p].y = cvt_pk_bf16(ha[2], ha[3]); oh[p].z = cvt_pk_bf16(hb[0], hb[1]); oh[p].w = cvt_pk_bf16(hb[2], hb[3]); \
                v[2 * p] = ha; v[2 * p + 1] = hb; } } \
        if (!OUTF && P.wr) { \
            float lg[8]; \
            _Pragma("unroll") for (int e = 0; e < 8; ++e) lg[e] = 0.f; \
            _Pragma("unroll") for (int j = 0; j < 4; ++j) _Pragma("unroll") for (int e4 = 0; e4 < 4; ++e4) { \
                const f32x4 wa = wrl[((j * 4 + e4) * 2 + 0) * 64 + lane], wb = wrl[((j * 4 + e4) * 2 + 1) * 64 + lane]; \
                _Pragma("unroll") for (int qq = 0; qq < 4; ++qq) { lg[qq] += v[j][e4] * wa[qq]; lg[4 + qq] += v[j][e4] * wb[qq]; } } \
            const float dd = router_reduce(lg, lane); \
            float lg8[8]; \
            _Pragma("unroll") for (int e = 0; e < 8; ++e) lg8[e] = __uint_as_float((unsigned)__builtin_amdgcn_readlane((int)__float_as_uint(dd), (e & 1) | (((e >> 1) & 1) << 4) | (((e >> 2) & 1) << 5))); \
            float v1 = lg8[0]; int e1 = 0; \
            _Pragma("unroll") for (int e = 1; e < 8; ++e) if (lg8[e] > v1) { v1 = lg8[e]; e1 = e; } \
            float v2 = -3.0e38f; int e2 = 0; \
            _Pragma("unroll") for (int e = 0; e < 8; ++e) if (e != e1 && lg8[e] > v2) { v2 = lg8[e]; e2 = e; } \
            const float ew = __expf(v2 - v1), wa_ = 1.0f / (1.0f + ew), wb_ = ew * wa_; \
            if (lane == 0) { ebuf[JOF(i_)] = e1 | (e2 << 8); P.tokw[TOK_E + c_row] = (unsigned)(e1 | (e2 << 8)); P.tokw[TOK_W + 2 * c_row] = __float_as_uint(wa_); P.tokw[TOK_W + 2 * c_row + 1] = __float_as_uint(wb_); } \
        } }
    RP_FILL(a, 0); { const int i1 = nj > 1 ? 1 : 0; RP_FILL(b, i1); } RP_PART(a);
    for (int i = 0; i < nj; i += 2) {
        RP_BODY(a, b, i);
        if (i + 1 >= nj) break;
        RP_BODY(b, a, i + 1);
    }
    RP_STORE();
#undef RP_FILL
#undef RP_PART
#undef RP_STORE
#undef RP_BODY
#undef JOF
    __syncthreads();
    if (P.wr) {
        if (tid < 16) { const int e = tid & 7, half = tid >> 3, j0 = half * (rpb >> 1); int c = 0;
            for (int j = j0; j < j0 + (rpb >> 1); ++j) { const int ee = ebuf[j]; const int row = brow0 + GRID * j;
                if ((ee & 255) == e) P.tokw[TOK_POS + 2 * row] = (unsigned)c++; if ((ee >> 8) == e) P.tokw[TOK_POS + 2 * row + 1] = (unsigned)c++; }
            P.tokw[TOK_BLK + (half * GRID + (int)blockIdx.x) * 8 + e] = (unsigned)c;
            if (c) __hip_atomic_fetch_add(P.cnt + half * 64 + e, (unsigned)c, __ATOMIC_RELAXED, __HIP_MEMORY_SCOPE_AGENT);
        }
        __syncthreads();
    }
}

#undef CB
#undef UNPK_LO
#undef UNPK_HI
typedef const __attribute__((address_space(4))) Args* KArgs;
__device__ __forceinline__ KArgs kargs() { unsigned long long p = (unsigned long long)__builtin_amdgcn_kernarg_segment_ptr(); asm volatile("" : "+s"(p)); return (KArgs)p; }

__device__ __forceinline__ void phase_prologue(LAS unsigned char* lds) {
    const KArgs a = kargs(); const int tid = fresh_tid(), lane = tid & 63, wave = __builtin_amdgcn_readfirstlane(tid >> 6);
    const int bid = blockIdx.x, G = gridDim.x; unsigned char* ws = a->ws;
    float* MOD = (float*)(ws + WS_MOD); float* ROPE = (float*)(ws + WS_ROPE);
    {
        LAS float* sc = (LAS float*)lds;
        LAS float* red = (LAS float*)(lds + 81920);
        const float* cc = a->c; const float* cctx = a->c_ctx;
        for (int idx = tid; idx < 17 * 1024; idx += 512) { const int r = idx >> 10, k = idx & 1023; const float v = r < 16 ? cc[r * 1024 + k] : cctx[k]; sc[k * 20 + r] = v / (1.0f + __expf(-v)); }
        __syncthreads();
        const float* wmod = a->w_mod; const float* bmod = a->b_mod;
        for (int item = bid; item < 4 * 96; item += G) {
            const int layer = item / 96, cb = item - layer * 96;
            const float* W = wmod + (size_t)layer * D * NMOD + cb * 64 + lane;
            float acc[17];
#pragma unroll
            for (int r = 0; r < 17; ++r) acc[r] = 0.f;
            for (int kb = 0; kb < 128; kb += 16) {
                float wv[16];
#pragma unroll
                for (int u = 0; u < 16; ++u) wv[u] = W[(size_t)(wave * 128 + kb + u) * NMOD];
#pragma unroll
                for (int u = 0; u < 16; ++u) { const int k = wave * 128 + kb + u; const float w = wv[u];
                    const f32x4 s0 = *(const LAS f32x4*)(sc + k * 20), s1 = *(const LAS f32x4*)(sc + k * 20 + 4), s2 = *(const LAS f32x4*)(sc + k * 20 + 8), s3 = *(const LAS f32x4*)(sc + k * 20 + 12); const float s4 = sc[k * 20 + 16];
#pragma unroll
                    for (int q = 0; q < 4; ++q) { acc[q] += w * s0[q]; acc[4 + q] += w * s1[q]; acc[8 + q] += w * s2[q]; acc[12 + q] += w * s3[q]; }
                    acc[16] += w * s4; } }
#pragma unroll
            for (int r = 0; r < 17; ++r) red[(wave * 17 + r) * 64 + lane] = acc[r];
            __syncthreads();
            for (int idx = tid; idx < 17 * 64; idx += 512) { const int r = idx >> 6, l = idx & 63; float s = 0.f;
#pragma unroll
                for (int w = 0; w < 8; ++w) s += red[(w * 17 + r) * 64 + l];
                MOD[((size_t)layer * 17 + r) * NMOD + cb * 64 + l] = s + bmod[layer * NMOD + cb * 64 + l]; }
            __syncthreads();
        }
    }
    if (bid == G - 1) {
        for (int idx = tid; idx < 1024; idx += 512) { const int pos = idx >> 4, i = idx & 15;
            const float inv = exp2f(-(float)(2 * i) * (13.287712379549449f / 32.0f)); const float ang = (float)pos * inv;
            ROPE[idx] = __cosf(ang); ROPE[1024 + idx] = __sinf(ang); }
        if (wave < 2) { const int j = wave; const float p1 = wave_sum(a->lq1[j * 64 + lane] * a->lk1[j * 64 + lane]), p2 = wave_sum(a->lq2[j * 64 + lane] * a->lk2[j * 64 + lane]);
            const float li = 0.8f - 0.6f * __expf(-0.3f * (float)(2 * j + 1));
            if (lane == 0) ROPE[2048 + j] = __expf(p1) - __expf(p2) + li; }
    }
    __syncthreads();
    {
        LAS float* scr = (LAS float*)(lds + wave * 8448);
        const int gw = bid * 8 + wave, NGW = G * 8; int rot = 0;
        convert_mats(a->a_w_qkv, D, NQA, 2, (bf16_t*)(ws + WS_WAQKV), 0, scr, gw, NGW, rot, lane);
        convert_mats(a->a_w_o, D, D, 2, (bf16_t*)(ws + WS_WAO), 0, scr, gw, NGW, rot, lane);
        convert_mats(a->b_w_qkv, D, NQB, 2, (bf16_t*)(ws + WS_WBQKV), 0, scr, gw, NGW, rot, lane);
        convert_mats(a->b_w_o, D, D, 2, (bf16_t*)(ws + WS_WBO), 0, scr, gw, NGW, rot, lane);
        convert_mats(a->ff_g, D, DFF, 2, (bf16_t*)(ws + WS_WFGU), 1, scr, gw, NGW, rot, lane);
        convert_mats(a->ff_u, D, DFF, 2, (bf16_t*)(ws + WS_WFGU), 2, scr, gw, NGW, rot, lane);
        convert_mats(a->ff_d, DFF, D, 2, (bf16_t*)(ws + WS_WFD), 0, scr, gw, NGW, rot, lane);
        convert_mats(a->moe_g, D, DFE, 16, (bf16_t*)(ws + WS_WMGU), 1, scr, gw, NGW, rot, lane);
        convert_mats(a->moe_u, D, DFE, 16, (bf16_t*)(ws + WS_WMGU), 2, scr, gw, NGW, rot, lane);
        convert_mats(a->moe_d, DFE, D, 16, (bf16_t*)(ws + WS_WMD), 0, scr, gw, NGW, rot, lane);
    }
    __syncthreads();
}

__device__ __forceinline__ void phase_mod0() {
    const KArgs a = kargs(); const int tid = fresh_tid(), lane = tid & 63, wave = __builtin_amdgcn_readfirstlane(tid >> 6);
    const int bid = blockIdx.x; unsigned char* ws = a->ws;
    const float* MOD = (const float*)(ws + WS_MOD); bf16_t* H = (bf16_t*)(ws + WS_H);
    const float* x = a->x; const float* ctx = a->ctx;
    const int rpb = MT / GRID;
    bf16_t* XB = (bf16_t*)(ws + WS_XB);
    for (int jr = wave; jr < rpb; jr += 16) {
        f32x4 xv[2][4]; int mr[2], rw[2];
#pragma unroll
        for (int q = 0; q < 2; ++q) { const int row = bid * rpb + jr + 8 * q; rw[q] = row; const bool lat = row < ML;
            const float* xr = lat ? x + (size_t)row * D : ctx + (size_t)(row - ML) * D; mr[q] = lat ? (row >> 11) : 16;
#pragma unroll
            for (int p = 0; p < 2; ++p) { xv[q][2 * p] = *(const f32x4*)(xr + 8 * lane + 512 * p); xv[q][2 * p + 1] = *(const f32x4*)(xr + 8 * lane + 512 * p + 4); } }
#pragma unroll
        for (int q = 0; q < 2; ++q)
#pragma unroll
            for (int p = 0; p < 2; ++p) { const int c8 = 8 * lane + 512 * p;
                const f32x4 sca = *(const f32x4*)(MOD + (size_t)mr[q] * NMOD + D + c8), scb = *(const f32x4*)(MOD + (size_t)mr[q] * NMOD + D + c8 + 4);
                const f32x4 sha = *(const f32x4*)(MOD + (size_t)mr[q] * NMOD + c8), shb = *(const f32x4*)(MOD + (size_t)mr[q] * NMOD + c8 + 4);
                const f32x4 xa = xv[q][2 * p], xb = xv[q][2 * p + 1];
                const f32x4 ha = xa * (sca + 1.0f) + sha, hb = xb * (scb + 1.0f) + shb;
                u32x4 w; w.x = cvt_pk_bf16(ha[0], ha[1]); w.y = cvt_pk_bf16(ha[2], ha[3]); w.z = cvt_pk_bf16(hb[0], hb[1]); w.w = cvt_pk_bf16(hb[2], hb[3]);
                *(u32x4*)(H + (size_t)rw[q] * D + c8) = w;
                u32x4 xw; xw.x = cvt_pk_bf16(xa[0], xa[1]); xw.y = cvt_pk_bf16(xa[2], xa[3]); xw.z = cvt_pk_bf16(xb[0], xb[1]); xw.w = cvt_pk_bf16(xb[2], xb[3]);
                *(u32x4*)(XB + (size_t)rw[q] * D + c8) = xw; }
    }
}

__device__ __forceinline__ void phase_qkv(LAS unsigned char* lds, int layer) {
    const KArgs a = kargs(); unsigned char* ws = a->ws;
    const bool typeB = layer & 1; const int j2 = layer >> 1; const int NQ = typeB ? NQB : NQA;
    const float* ROPE = (const float*)(ws + WS_ROPE);
    LAS float* rl = (LAS float*)(lds + RING_BYTES);
    { const int tid = fresh_tid(); *(LAS f32x4*)(rl + 4 * tid) = *(const f32x4*)(ROPE + 4 * tid); }
    __syncthreads();
    pg8::Gemm g{(const bf16_t*)(ws + WS_H), typeB ? (const bf16_t*)(ws + WS_WBQKV) + (size_t)j2 * NQB * D : (const bf16_t*)(ws + WS_WAQKV) + (size_t)j2 * NQA * D, D};
    pg8::GroupOrder S; S.init(MT / 256, NQ / 256, gridDim.x, blockIdx.x, D / 64);
    pg8::EpiQKV E{(bf16_t*)(ws + WS_BIG), NQ, typeB ? 8 : 5, 4, ML / 256, rl, rl + 1024};
    pg8::gemm_phase<pg8::EpiQKV, pg8::GroupOrder>(lds, g, S, E);
}

__device__ __forceinline__ void phase_attn(LAS unsigned char* lds, int layer) {
    const KArgs a = kargs(); unsigned char* ws = a->ws;
    const int tid = fresh_tid(); const int wave = __builtin_amdgcn_readfirstlane(tid >> 6);
    const bool typeB = layer & 1; const int j2 = layer >> 1; const bool with_ctx = layer < DEPTH - 1;
    const int bid = blockIdx.x; const int x8 = bid & 7, y = bid >> 3;
    const bf16_t* QKV = (const bf16_t*)(ws + WS_BIG); bf16_t* O = (bf16_t*)(ws + WS_H);
    const int sub = wave >> 2, w4 = wave & 3;
    if (!typeB) {
        const float* sink = a->a_sink;
        for (int i = 0; i < (with_ctx ? 9 : 8); ++i) {
            att::UnitD U; int b, p, n;
            if (i < 8) { const int bp = i * 16 + x8 * 2 + (y >> 4); b = bp >> 3; p = bp & 7; n = (y + 2 * i) & 15;
                const int j0 = n == 0 ? 2 : 0, j1 = n == 15 ? 4 : 6;
                U.qrow0 = b * SEQ + n * 128; U.n1 = 4; U.base1 = ML + b * CTXL; U.n2 = j1 - j0; U.base2 = b * SEQ + (n - 1) * 128 + 64 * j0;
                U.kp0 = (n - 1) * 128 + 64 * j0; U.qp0 = n * 128 + w4 * 32; U.masked = 1;
            } else { b = bid >> 4; p = (bid >> 1) & 7; n = bid & 1;
                U.qrow0 = ML + b * CTXL + n * 128; U.n1 = 4; U.base1 = ML + b * CTXL; U.n2 = 0; U.base2 = 0; U.kp0 = 0; U.qp0 = 0; U.masked = 0; }
            const int head = 2 * p + sub;
            U.qcol = head * 64; U.kcol = 1024 + (p >> 1) * 64; U.vcol = 1280 + (p >> 1) * 64; U.ocol = head * 64;
            U.sink2 = sink[j2 * 16 + head] * LOG2E; U.use_sink = 1; U.diag = nullptr;
            att::attn_unit<false>(lds, QKV, NQA, O, U, 0.f, 0.f, nullptr);
        }
    } else {
        const float lam = ((const float*)(ws + WS_ROPE))[2048 + j2];
        const float post = 1.0f - (0.8f - 0.6f * __expf(-0.3f * (float)layer));
        const float* subln = a->subln + j2 * 128;
        for (int i = 0; i < (with_ctx ? 9 : 8); ++i) {
            att::UnitD U; int b, p, n;
            if (i < 8) { const int bp = i * 16 + x8 * 2 + (y >> 4); b = bp >> 3; p = bp & 7; n = y & 15;
                U.qrow0 = b * SEQ + n * 128; U.n1 = 32; U.base1 = b * SEQ; U.n2 = 4; U.base2 = ML + b * CTXL;
            } else { b = bid >> 4; p = (bid >> 1) & 7; n = bid & 1;
                U.qrow0 = ML + b * CTXL + n * 128; U.n1 = 4; U.base1 = ML + b * CTXL; U.n2 = 0; U.base2 = 0; }
            U.kp0 = 0; U.qp0 = 0; U.masked = 0; U.sink2 = 0.f; U.use_sink = 0; U.diag = (DIAG_SEL && bid == 0 && i == 3 && layer == 1) ? (unsigned*)(ws + WS_CTL) + 16384 : nullptr;
            U.qcol = (2 * p + sub) * 64; U.kcol = 1024 + 2 * p * 64; U.vcol = 2048 + p * 128; U.ocol = p * 128;
            att::attn_unit<true>(lds, QKV, NQB, O, U, lam, post, subln);
        }
    }
    __syncthreads();
}

__device__ __forceinline__ void phase_oproj(LAS unsigned char* lds, int layer) {
    const KArgs a = kargs(); unsigned char* ws = a->ws;
    const bool typeB = layer & 1; const int j2 = layer >> 1; const int rows_out = (layer < DEPTH - 1) ? MT : ML;
    pg8::Gemm g{(const bf16_t*)(ws + WS_H), typeB ? (const bf16_t*)(ws + WS_WBO) + (size_t)j2 * D * D : (const bf16_t*)(ws + WS_WAO) + (size_t)j2 * D * D, D};
    pg8::GroupOrder S; S.init(rows_out / 256, D / 256, gridDim.x, blockIdx.x, D / 64, NSPLIT_TILE0);
    pg8::EpiBf16 E{(bf16_t*)(ws + WS_BIG), D, (bf16_t*)(ws + WS_PARTS) - (size_t)SPLIT_ROW0 * D, PART_STRIDE};
    pg8::gemm_phase<pg8::EpiBf16, pg8::GroupOrder>(lds, g, S, E);
}

__device__ __forceinline__ void phase_ln1(LAS unsigned char* lds, int layer, bool dummy = false) {
    const KArgs a = kargs(); unsigned char* ws = a->ws;
    const int tid = fresh_tid(), lane = tid & 63, wave = __builtin_amdgcn_readfirstlane(tid >> 6);
    const bool typeB = layer & 1; const int j2 = layer >> 1; const int rows_out = (layer < DEPTH - 1) ? MT : ML;
    const float* modL = (const float*)(ws + WS_MOD) + (size_t)layer * 17 * NMOD;
    RowP P; P.xin_b = (const bf16_t*)(ws + WS_XB); P.xout_b = (bf16_t*)(ws + WS_XB); P.xout_f = nullptr;
    P.F = (const bf16_t*)(ws + WS_BIG); P.Fp = (const bf16_t*)(ws + WS_PARTS) - (size_t)SPLIT_ROW0 * D; P.mod_gate = modL + 2 * D; P.lg = a->ln_g + (layer * 2 + 0) * D; P.lb = a->ln_b + (layer * 2 + 0) * D;
    P.mod_sc = modL + 4 * D; P.mod_sh = modL + 3 * D; P.H = (bf16_t*)(ws + WS_H); P.tok = nullptr; P.two = 0;
    P.wr = typeB ? a->moe_r + (size_t)j2 * D * 8 : nullptr; P.cnt = (unsigned*)(ws + WS_CTL) + CW_CNT + j2 * 128; P.tokw = (unsigned*)(ws + WS_TOK);
    if (dummy) { P.wr = nullptr; P.xout_b = (bf16_t*)(ws + WS_END); P.H = (bf16_t*)(ws + WS_END); }
    row_phase<false, false>(P, 0, rows_out, lds, tid, lane, wave, rows_out / 2);
}

__device__ __forceinline__ void tile_starts(const unsigned char* ws, bool typeB, int j2, int half, int hrows, int (&ts)[9]) {
    ts[0] = 0;
    if (typeB) { const unsigned* cnt = (const unsigned*)(ws + WS_CTL) + CW_CNT + j2 * 128 + half * 64;
#pragma unroll
        for (int e = 0; e < 8; ++e) ts[e + 1] = ts[e] + (int)((__builtin_amdgcn_readfirstlane(cnt[e]) + 255u) >> 8);
    } else {
#pragma unroll
        for (int e = 0; e < 8; ++e) ts[e + 1] = hrows / 256; }
}

__device__ __forceinline__ void phase_gather(LAS unsigned char* lds, int layer, int half) {
    const KArgs a = kargs(); unsigned char* ws = a->ws;
    const int tid = fresh_tid(), lane = tid & 63, wave = __builtin_amdgcn_readfirstlane(tid >> 6);
    const int j2 = layer >> 1; const int rows_out = (layer < DEPTH - 1) ? MT : ML; const int hrows = rows_out / 2, row_lo = half * hrows;
    int ts[9]; tile_starts(ws, true, j2, half, hrows, ts);
    unsigned* TOK = (unsigned*)(ws + WS_TOK); const bf16_t* H = (const bf16_t*)(ws + WS_H); bf16_t* HG = (bf16_t*)(ws + (half ? WS_HG1 : WS_BIG));
    const int rpb = hrows / GRID;
    LAS unsigned* bs = (LAS unsigned*)lds;
    { const int bb = (int)blockIdx.x;
      if (wave == 0) { unsigned a8[8];
#pragma unroll
          for (int e = 0; e < 8; ++e) a8[e] = 0u;
#pragma unroll
          for (int k = 0; k < 4; ++k) { const int b = lane + 64 * k; const u32x4 c0 = *(const u32x4*)(TOK + TOK_BLK + (half * GRID + b) * 8), c1 = *(const u32x4*)(TOK + TOK_BLK + (half * GRID + b) * 8 + 4);
              if (b < bb) { a8[0] += c0.x; a8[1] += c0.y; a8[2] += c0.z; a8[3] += c0.w; a8[4] += c1.x; a8[5] += c1.y; a8[6] += c1.z; a8[7] += c1.w; } }
#pragma unroll
          for (int e = 0; e < 8; ++e) {
#pragma unroll
              for (int o = 1; o < 64; o <<= 1) a8[e] += __shfl_xor(a8[e], o);
              if (lane == 0) bs[e] = a8[e]; } }
      __syncthreads(); }
    unsigned base8[8];
#pragma unroll
    for (int e = 0; e < 8; ++e) base8[e] = bs[e];
    unsigned short* RIDX = (unsigned short*)(ws + WS_CTL + CTL_RIDX) + (size_t)half * RIDX_HALF;
    for (int jr = tid; jr < rpb; jr += 512) {
        const int row = row_lo + (int)blockIdx.x + GRID * jr;
        const unsigned ee = TOK[TOK_E + row]; const int e1 = ee & 255, e2 = ee >> 8;
        int t1 = 0, t2 = 0;
#pragma unroll
        for (int e = 0; e < 8; ++e) { t1 = (e1 == e) ? ts[e] * 256 + (int)base8[e] : t1; t2 = (e2 == e) ? ts[e] * 256 + (int)base8[e] : t2; }
        const int s1 = t1 + (int)TOK[TOK_POS + 2 * row], s2 = t2 + (int)TOK[TOK_POS + 2 * row + 1];
        TOK[TOK_SLOT + 2 * row] = (unsigned)s1; TOK[TOK_SLOT + 2 * row + 1] = (unsigned)s2;
        RIDX[s1] = (unsigned short)row; RIDX[s2] = (unsigned short)row; }
}

__device__ __forceinline__ void phase_gu(LAS unsigned char* lds, int layer, int half) {
    const KArgs a = kargs(); unsigned char* ws = a->ws;
    const bool typeB = layer & 1; const int j2 = layer >> 1; const int rows_out = (layer < DEPTH - 1) ? MT : ML; const int hrows = typeB ? rows_out / 2 : rows_out;
    int ts[9]; tile_starts(ws, typeB, j2, half, hrows, ts);
    const int dff = typeB ? DFE : DFF;
    pg8::Gemm g{(const bf16_t*)(ws + WS_H), typeB ? (const bf16_t*)(ws + WS_WMGU) + (size_t)j2 * NEXP * 2 * DFE * D : (const bf16_t*)(ws + WS_WFGU) + (size_t)j2 * 2 * DFF * D, D};
    pg8::GroupOrder S; S.init(ts[8], 2 * dff / 256, gridDim.x, blockIdx.x, D / 64);
    pg8::EpiSwiglu E{(bf16_t*)(ws + WS_HID), dff};
    if (typeB) { S.ts1 = ts[1]; S.ts2 = ts[2]; S.ts3 = ts[3]; S.ts4 = ts[4]; S.ts5 = ts[5]; S.ts6 = ts[6]; S.ts7 = ts[7];
        pg8::gemm_phase<pg8::EpiSwiglu, pg8::GroupOrder, true>(lds, g, S, E, (const unsigned short*)(ws + WS_CTL + CTL_RIDX) + (size_t)half * RIDX_HALF);
    } else pg8::gemm_phase<pg8::EpiSwiglu, pg8::GroupOrder, false>(lds, g, S, E);
}

__device__ __forceinline__ void phase_down(LAS unsigned char* lds, int layer, int half) {
    const KArgs a = kargs(); unsigned char* ws = a->ws;
    const bool typeB = layer & 1; const int j2 = layer >> 1; const int rows_out = (layer < DEPTH - 1) ? MT : ML; const int hrows = typeB ? rows_out / 2 : rows_out;
    int ts[9]; tile_starts(ws, typeB, j2, half, hrows, ts);
    const int dff = typeB ? DFE : DFF;
    pg8::Gemm g{(const bf16_t*)(ws + WS_HID), typeB ? (const bf16_t*)(ws + WS_WMD) + (size_t)j2 * NEXP * D * DFE : (const bf16_t*)(ws + WS_WFD) + (size_t)j2 * D * DFF, dff};
    pg8::GroupOrder S; S.init(ts[8], D / 256, gridDim.x, blockIdx.x, dff / 64, NSPLIT_TILE0);
    if (typeB) { S.ts1 = ts[1]; S.ts2 = ts[2]; S.ts3 = ts[3]; S.ts4 = ts[4]; S.ts5 = ts[5]; S.ts6 = ts[6]; S.ts7 = ts[7]; }
    pg8::EpiBf16 E{(bf16_t*)(ws + WS_BIG), D, (bf16_t*)(ws + WS_PARTS) - (size_t)SPLIT_ROW0 * D, PART_STRIDE};
    pg8::gemm_phase<pg8::EpiBf16, pg8::GroupOrder>(lds, g, S, E);
}

__device__ __forceinline__ void phase_ln2(LAS unsigned char* lds, int layer, int half, bool dummy = false) {
    const KArgs a = kargs(); unsigned char* ws = a->ws;
    const int tid = fresh_tid(), lane = tid & 63, wave = __builtin_amdgcn_readfirstlane(tid >> 6);
    const bool typeB = layer & 1; const int rows_out = (layer < DEPTH - 1) ? MT : ML; const int hrows = typeB ? rows_out / 2 : rows_out;
    const float* modL = (const float*)(ws + WS_MOD) + (size_t)layer * 17 * NMOD; const float* modN = modL + 17 * NMOD;
    RowP P; P.xin_b = (const bf16_t*)(ws + WS_XB); const bool lastsub = layer + 1 == DEPTH; P.xout_b = lastsub ? nullptr : (bf16_t*)(ws + WS_XB); P.xout_f = a->out;
    P.F = (const bf16_t*)(ws + WS_BIG); P.Fp = (const bf16_t*)(ws + WS_PARTS) - (size_t)SPLIT_ROW0 * D; P.mod_gate = modL + 5 * D; P.lg = a->ln_g + (layer * 2 + 1) * D; P.lb = a->ln_b + (layer * 2 + 1) * D;
    const bool nextmod = layer + 1 < DEPTH;
    P.mod_sc = nextmod ? modN + D : nullptr; P.mod_sh = nextmod ? modN : nullptr; P.H = (bf16_t*)(ws + WS_H); P.tok = (const unsigned*)(ws + WS_TOK); P.two = typeB ? 1 : 0;
    P.wr = nullptr; P.cnt = nullptr; P.tokw = nullptr;
    if (dummy) { P.xout_b = (bf16_t*)(ws + WS_END); P.H = (bf16_t*)(ws + WS_END); }
    if (!typeB) row_phase<false, false>(P, half * hrows, hrows, lds, tid, lane, wave, hrows);
    else if (nextmod) row_phase<true, false>(P, half * hrows, hrows, lds, tid, lane, wave, hrows);
    else row_phase<true, true>(P, half * hrows, hrows, lds, tid, lane, wave, hrows);
}

__global__ void __launch_bounds__(512, 2) dit_fwd(Args a_unused) {
    extern __shared__ __attribute__((aligned(16))) unsigned char lds_raw[];
    LAS unsigned char* lds = (LAS unsigned char*)lds_raw;
    volatile LAS unsigned* MISC = (volatile LAS unsigned*)(lds + MISC_OFF);
    for (int u = threadIdx.x; u < (LDS_BYTES - LDSCTL_OFF) / 4; u += 512) ((LAS unsigned*)(lds + LDSCTL_OFF))[u] = 0u;
    __syncthreads();
    int ph_lo, ph_hi;
    XcdBarrier bar;
    { const KArgs a = kargs(); ph_lo = a->ph_lo; ph_hi = a->ph_hi; bar = xcd_barrier_post((unsigned*)(a->ws + WS_CTL) + CW_BAR, MISC + 8); }
    int ph = 0; unsigned long long dbar = 0;
#define PH_ON (ph >= ph_lo && ph < ph_hi)
#define PH_END do { const bool _both = (ph >= ph_lo) && (ph + 1 < ph_hi); ++ph; if (_both) { unsigned long long _b0 = 0; if (DIAG_SEL >= 12) _b0 = __builtin_amdgcn_s_memrealtime(); xcd_barrier(bar); if (DIAG_SEL >= 12) dbar += __builtin_amdgcn_s_memrealtime() - _b0; if (PROBE_MASK & 32) xcd_barrier(bar); } } while (0)
    if (PH_ON) { phase_prologue(lds); if (PROBE_MASK & 16) phase_prologue(lds); }
    PH_END;
    if (PH_ON) { phase_mod0(); if (PROBE_MASK & 64) phase_mod0(); }
    PH_END;
    for (int layer = 0; layer < DEPTH; ++layer) {
        if (PH_ON) { phase_qkv(lds, layer); if (PROBE_MASK & 1) phase_qkv(lds, layer); }
        PH_END;
        if (PH_ON) { phase_attn(lds, layer); if ((PROBE_MASK & 8) || ((PROBE_MASK & 128) && (layer & 1)) || ((PROBE_MASK & 256) && !(layer & 1))) phase_attn(lds, layer); }
        PH_END;
        if (PH_ON) { phase_oproj(lds, layer); if (PROBE_MASK & 1) phase_oproj(lds, layer); }
        PH_END;
        if (PH_ON) { phase_ln1(lds, layer); if (PROBE_MASK & 64) phase_ln1(lds, layer, true); }
        PH_END;
        if (!(layer & 1)) {
            if (PH_ON) { phase_gu(lds, layer, 0); if (PROBE_MASK & 2) phase_gu(lds, layer, 0); }
            PH_END;
            if (PH_ON) { phase_down(lds, layer, 0); if (PROBE_MASK & 4) phase_down(lds, layer, 0); }
            PH_END;
            if (PH_ON) { phase_ln2(lds, layer, 0); if (PROBE_MASK & 64) phase_ln2(lds, layer, 0, true); }
            PH_END;
        } else {
            if (PH_ON) { phase_gather(lds, layer, 0); __syncthreads(); phase_gather(lds, layer, 1); }
            PH_END;
            if (PH_ON) phase_gu(lds, layer, 0);
            PH_END;
            if (PH_ON) phase_down(lds, layer, 0);
            PH_END;
            if (PH_ON) { if (blockIdx.x & 1) { phase_gu(lds, layer, 1); phase_ln2(lds, layer, 0); } else { phase_ln2(lds, layer, 0); phase_gu(lds, layer, 1); } }
            PH_END;
            if (PH_ON) phase_down(lds, layer, 1);
            PH_END;
            if (PH_ON) phase_ln2(lds, layer, 1);
            PH_END;
        }
    }
#undef PH_ON
#undef PH_END
    if (DIAG_SEL >= 12 && threadIdx.x == 0 && (blockIdx.x == (DIAG_SEL == 12 ? 0 : (DIAG_SEL == 13 ? 100 : 255)))) { const KArgs a = kargs(); __hip_atomic_store((unsigned*)(a->ws + WS_CTL) + 16384 + DIAG_SEL, (unsigned)(dbar >> 3), __ATOMIC_RELAXED, __HIP_MEMORY_SCOPE_AGENT); }
    if (DIAG_SEL >= 12) { __syncthreads(); if (blockIdx.x == 0) { xcd_barrier(bar); } else xcd_barrier(bar); }
    if (DIAG_SEL && blockIdx.x == 0 && threadIdx.x == 0) { const KArgs a = kargs(); const unsigned d = __hip_atomic_load((unsigned*)(a->ws + WS_CTL) + 16384 + DIAG_SEL, __ATOMIC_RELAXED, __HIP_MEMORY_SCOPE_AGENT);
        const unsigned long long t0 = __builtin_amdgcn_s_memrealtime(); while (__builtin_amdgcn_s_memrealtime() - t0 < 16ull * d) __builtin_amdgcn_s_sleep(8); }
}

constexpr int NPHASES = 2 + 2 * (4 + 3) + 2 * (4 + 6);

extern "C" void kernel_launch(void* const* d_in, const int* in_sizes, int n_in, void* d_out, int out_size, void* d_ws, size_t ws_size, hipStream_t stream) {
    static int ready = 0;
    if (ready == 0) {
        if (n_in != 25 || out_size != ML * D || ws_size < WS_END) { fprintf(stderr, "kernel_launch: unexpected shapes (n_in %d out %d ws %zu); nothing launched\n", n_in, out_size, ws_size); ready = -1; return; }
        int dev = 0, cus = 0, per_cu = 0;
        if (hipGetDevice(&dev) != hipSuccess || hipDeviceGetAttribute(&cus, hipDeviceAttributeMultiprocessorCount, dev) != hipSuccess) { ready = -1; return; }
        if (hipFuncSetAttribute((const void*)dit_fwd, hipFuncAttributeMaxDynamicSharedMemorySize, LDS_BYTES) != hipSuccess) { fprintf(stderr, "kernel_launch: hipFuncSetAttribute failed\n"); ready = -1; return; }
        if (hipOccupancyMaxActiveBlocksPerMultiprocessor(&per_cu, (const void*)dit_fwd, 512, LDS_BYTES) != hipSuccess || per_cu < 1) fprintf(stderr, "kernel_launch: occupancy query reports %d\n", per_cu);
        (void)hipGetLastError();
        if (cus < GRID) { fprintf(stderr, "kernel_launch: %d CUs < %d; nothing launched\n", cus, GRID); ready = -1; return; }
        ready = 1;
    }
    if (ready < 0) return;
    if (hipMemsetAsync((char*)d_ws + WS_CTL, 0, CTL_ZERO_BYTES, stream) != hipSuccess) return;
    Args a{};
    a.x = (const float*)d_in[0]; a.c = (const float*)d_in[1]; a.ctx = (const float*)d_in[2]; a.c_ctx = (const float*)d_in[3]; a.w_mod = (const float*)d_in[4]; a.b_mod = (const float*)d_in[5];
    a.ln_g = (const float*)d_in[6]; a.ln_b = (const float*)d_in[7]; a.a_w_qkv = (const float*)d_in[8]; a.a_sink = (const float*)d_in[9]; a.a_w_o = (const float*)d_in[10];
    a.b_w_qkv = (const float*)d_in[11]; a.lq1 = (const float*)d_in[12]; a.lk1 = (const float*)d_in[13]; a.lq2 = (const float*)d_in[14]; a.lk2 = (const float*)d_in[15];
    a.subln = (const float*)d_in[16]; a.b_w_o = (const float*)d_in[17]; a.ff_g = (const float*)d_in[18]; a.ff_u = (const float*)d_in[19]; a.ff_d = (const float*)d_in[20];
    a.moe_r = (const float*)d_in[21]; a.moe_g = (const float*)d_in[22]; a.moe_u = (const float*)d_in[23]; a.moe_d = (const float*)d_in[24];
    a.out = (float*)d_out; a.ws = (unsigned char*)d_ws;
#if MK_LAUNCH_MODE == 0
    a.ph_lo = 0; a.ph_hi = NPHASES;
    hipLaunchKernelGGL(dit_fwd, dim3(GRID), dim3(512), LDS_BYTES, stream, a);
#else
    for (int k = 0; k < NPHASES; ++k) { a.ph_lo = k; a.ph_hi = k + 1; hipLaunchKernelGGL(dit_fwd, dim3(GRID), dim3(512), LDS_BYTES, stream, a); }
#endif
    const hipError_t le = hipPeekAtLastError();
    if (le != hipSuccess) fprintf(stderr, "kernel_launch: launch failed: %s\n", hipGetErrorName(le));
}
```

```cpp
#include <hip/hip_runtime.h>
#include <cstdio>
#include <cstdint>

#ifndef MK_LAUNCH_MODE
#define MK_LAUNCH_MODE 0
#endif

#ifndef PROBE_MASK
#define PROBE_MASK 0
#endif
#ifndef ATT_PROBE
#define ATT_PROBE 0
#endif
#ifndef DIAG_SEL
#define DIAG_SEL 0
#endif
#ifndef DIAG_WAVE
#define DIAG_WAVE 0
#endif
#define LAS __attribute__((address_space(3)))
#define GAS __attribute__((address_space(1)))
typedef unsigned short bf16_t;
typedef short bf16x8 __attribute__((ext_vector_type(8)));
typedef short s16x4 __attribute__((ext_vector_type(4)));
typedef float f32x4 __attribute__((ext_vector_type(4)));
typedef float f32x2 __attribute__((ext_vector_type(2)));
typedef float f32x16 __attribute__((ext_vector_type(16)));
typedef unsigned u32x4 __attribute__((ext_vector_type(4)));
typedef unsigned u32x2 __attribute__((ext_vector_type(2)));

constexpr int D = 1024, NBATCH = 16, SEQ = 2048, CTXL = 256, DEPTH = 4;
constexpr int ML = NBATCH * SEQ;
constexpr int MC = NBATCH * CTXL;
constexpr int MT = ML + MC;
constexpr int DFF = 2816, NEXP = 8, DFE = 3584;
constexpr int NQA = 1536, NQB = 3072;
constexpr int NMOD = 6 * D;
constexpr float LN_EPS = 1e-5f, RMS_EPS = 1e-5f;
constexpr float DN_ALPHA = 1.681792830507429f;
constexpr float QSCALE = 0.125f * 1.4426950408889634f;
constexpr float LOG2E = 1.4426950408889634f;
constexpr int GRID = 256;

constexpr size_t MiB = 1u << 20;
constexpr size_t WS_CTL = 0, CTL_ZERO_BYTES = 1 * MiB;
constexpr size_t WS_MOD = 1 * MiB;
constexpr size_t WS_ROPE = 3 * MiB;
constexpr size_t WS_TOK = 4 * MiB;
constexpr size_t WS_XC = 8 * MiB;
constexpr size_t WS_WAQKV = 24 * MiB;
constexpr size_t WS_WAO = 30 * MiB;
constexpr size_t WS_WBQKV = 34 * MiB;
constexpr size_t WS_WBO = 46 * MiB;
constexpr size_t WS_WFGU = 50 * MiB;
constexpr size_t WS_WFD = 72 * MiB;
constexpr size_t WS_WMGU = 84 * MiB;
constexpr size_t WS_WMD = 308 * MiB;
constexpr size_t WS_H = 420 * MiB;
constexpr size_t WS_BIG = 492 * MiB;
constexpr size_t WS_HID = 568 * MiB;
constexpr size_t WS_PARTS = 834 * MiB;
constexpr size_t WS_XB = 872 * MiB;
constexpr size_t WS_HG1 = 944 * MiB;
constexpr size_t WS_END = 1020 * MiB;
constexpr int NSPLIT_TILE0 = 128, SPLIT_ROW0 = NSPLIT_TILE0 * 256;
constexpr size_t PART_STRIDE = (size_t)6144 * 1024;
static_assert(WS_WFD + (size_t)2 * 1024 * 2816 * 2 <= WS_WMGU, "ws map");
static_assert(WS_WMGU + (size_t)2 * 8 * 7168 * 1024 * 2 <= WS_WMD, "ws map");
static_assert(WS_WMD + (size_t)2 * 8 * 1024 * 3584 * 2 <= WS_H, "ws map");
static_assert(WS_BIG + (size_t)MT * NQB * 2 <= WS_END && WS_HID + (size_t)38912 * DFE * 2 <= WS_END, "ws map");
constexpr int TOK_E = 0, TOK_W = MT, TOK_POS = 3 * MT, TOK_SLOT = 5 * MT;
constexpr int TOK_BLK = 7 * MT;
constexpr int CW_BAR = 4096;
constexpr int CW_CNT = 8192;
constexpr size_t CTL_RIDX = 262144;
constexpr int RIDX_HALF = 38912;

constexpr int RING_BYTES = 131072;
constexpr int LDSCTL_OFF = 143360, MISC_OFF = LDSCTL_OFF + 320;
constexpr int LDS_BYTES = 147456;

#define LDS_WAIT() asm volatile("s_waitcnt lgkmcnt(0)" ::: "memory")
#define VM_WAIT() asm volatile("s_waitcnt vmcnt(0)" ::: "memory")

__device__ __forceinline__ unsigned cvt_pk_bf16(float lo, float hi) { unsigned r; asm volatile("v_cvt_pk_bf16_f32 %0, %1, %2" : "=v"(r) : "v"(lo), "v"(hi)); return r; }
typedef float f32x2_t __attribute__((ext_vector_type(2))); typedef __bf16 bf16x2_t __attribute__((ext_vector_type(2)));
__device__ __forceinline__ unsigned cvtpk_s(float lo, float hi) { f32x2_t v = {lo, hi}; bf16x2_t b = __builtin_convertvector(v, bf16x2_t); return __builtin_bit_cast(unsigned, b); }
__device__ __forceinline__ float bf_lo(unsigned w) { return __uint_as_float(w << 16); }
__device__ __forceinline__ float bf_hi(unsigned w) { return __uint_as_float(w & 0xffff0000u); }
__device__ __forceinline__ int fresh_tid() { int t = threadIdx.x; asm volatile("" : "+v"(t)); return t; }
template <int CTRL> __device__ __forceinline__ float dpp_xadd(float v) { return v + __int_as_float(__builtin_amdgcn_update_dpp(0, __float_as_int(v), CTRL, 0xF, 0xF, true)); }
__device__ __forceinline__ float wave_allsum(float v) {
    v = dpp_xadd<0xB1>(v); v = dpp_xadd<0x4E>(v); v = dpp_xadd<0x141>(v); v = dpp_xadd<0x140>(v);
    { auto r = __builtin_amdgcn_permlane16_swap(__float_as_uint(v), __float_as_uint(v), false, false); v = __uint_as_float(r[0]) + __uint_as_float(r[1]); }
    { auto r = __builtin_amdgcn_permlane32_swap(__float_as_uint(v), __float_as_uint(v), false, false); v = __uint_as_float(r[0]) + __uint_as_float(r[1]); }
    return v;
}
template <int CTRL> __device__ __forceinline__ unsigned dpp_xaddu(unsigned v) { return v + (unsigned)__builtin_amdgcn_update_dpp(0, (int)v, CTRL, 0xF, 0xF, true); }
__device__ __forceinline__ unsigned wave_allsum_u(unsigned v) {
    v = dpp_xaddu<0xB1>(v); v = dpp_xaddu<0x4E>(v); v = dpp_xaddu<0x141>(v); v = dpp_xaddu<0x140>(v);
    { auto r = __builtin_amdgcn_permlane16_swap(v, v, false, false); v = r[0] + r[1]; }
    { auto r = __builtin_amdgcn_permlane32_swap(v, v, false, false); v = r[0] + r[1]; }
    return v;
}
__device__ __forceinline__ float half_allsum(float v) {
    v = dpp_xadd<0xB1>(v); v = dpp_xadd<0x4E>(v); v = dpp_xadd<0x141>(v); v = dpp_xadd<0x140>(v);
    { auto r = __builtin_amdgcn_permlane16_swap(__float_as_uint(v), __float_as_uint(v), false, false); v = __uint_as_float(r[0]) + __uint_as_float(r[1]); }
    return v;
}
__device__ __forceinline__ float wave_sum(float v) { return wave_allsum(v); }

namespace pg8 {
constexpr int BM = 256, BK = 64, HALF = 128, HTB = HALF * BK * 2, STAGE_BYTES = 8 * HTB, NXCD = 8, WGM = 8;
__host__ __device__ __forceinline__ int lds_byte(int r, int c) { return r * 128 + ((((c >> 3) ^ (r >> 1)) & 7) << 4) + (c & 7) * 2; }
__host__ __device__ __forceinline__ void stage_rc(int b, int& R, int& C) { R = b >> 7; C = ((((b >> 4) ^ (R >> 1)) & 7) << 3) + ((b & 15) >> 1); }
__host__ __device__ __forceinline__ int perm32(int rho) { const int n = rho >> 4, i = rho & 15; return 8 * (i >> 2) + 4 * n + (i & 3); }

struct Unit { int pm, pn, pb, kt0, nkt, part; };
struct Gemm { const bf16_t* A; const bf16_t* Bt; int K; unsigned* diag = nullptr; };

struct GroupOrder {
    int nM, nN, nwg, G, c, nMf, nfull, KT;
    int ts1, ts2, ts3, ts4, ts5, ts6, ts7;
    __device__ __forceinline__ void init(int nM_, int nN_, int G_, int c_, int KT_, int nMf_ = 0x7fffffff) {
        nM = nM_; nN = nN_; G = G_; c = c_; KT = KT_; nMf = nMf_ < nM_ ? nMf_ : nM_; nfull = nMf * nN; nwg = nfull + 4 * (nM - nMf) * nN;
        ts1 = ts2 = ts3 = ts4 = ts5 = ts6 = ts7 = 0x7fffffff; }
    __device__ __forceinline__ bool next(int i, Unit& u) const {
        const long L = (long)i * G + c; if (L >= nwg) return false;
        int pm, pn, kt0, nkt, part;
        if (L < nfull) {
            int wgid = (int)L; { const int q = nfull / NXCD, r = nfull % NXCD, xcd = wgid % NXCD, off = wgid / NXCD; wgid = (xcd < r ? xcd * (q + 1) : r * (q + 1) + (xcd - r) * q) + off; }
            const int nig = WGM * nN, gid = wgid / nig, fm = gid * WGM, gsz = (nMf - fm) < WGM ? (nMf - fm) : WGM;
            pm = fm + ((wgid % nig) % gsz); pn = (wgid % nig) / gsz; kt0 = 0; nkt = KT; part = 0;
        } else {
            const int Ls = (int)L - nfull, uu = Ls >> 2; part = Ls & 3;
            pm = nMf + uu / nN; pn = uu % nN;
            const int base = (KT >> 2) & ~1, rem2 = (KT - 4 * base) >> 1;
            nkt = base + (part < rem2 ? 2 : 0); kt0 = part * base + 2 * (part < rem2 ? part : rem2);
        }
        u.pm = pm; u.pn = pn; u.kt0 = kt0; u.nkt = nkt; u.part = part;
        const int e = (pm >= ts1) + (pm >= ts2) + (pm >= ts3) + (pm >= ts4) + (pm >= ts5) + (pm >= ts6) + (pm >= ts7);
        u.pb = e * nN + pn; return true;
    }
};

struct EpiBf16 {
    static constexpr bool PERM = true;
    bf16_t* O0; int ldc; bf16_t* Op; size_t pstride;
    __device__ __forceinline__ void operator()(const f32x4 (&acc)[2][2][4][2], const Unit& u, int wr, int wc, int fr, int fq) const {
        bf16_t* O = u.part == 0 ? O0 : Op + (size_t)(u.part - 1) * pstride;
        const int row0 = u.pm * BM + wr * 64 + fr, col0 = u.pn * BM + wc * 32 + 8 * fq;
#pragma unroll
        for (int ai = 0; ai < 2; ++ai)
#pragma unroll
            for (int m = 0; m < 4; ++m) { bf16_t* rowp = O + (size_t)(row0 + ai * HALF + m * 16) * ldc + col0;
#pragma unroll
                for (int bj = 0; bj < 2; ++bj) { const f32x4 v0 = acc[ai][bj][m][0], v1 = acc[ai][bj][m][1];
                    u32x4 w; w.x = cvtpk_s(v0[0], v0[1]); w.y = cvtpk_s(v0[2], v0[3]); w.z = cvtpk_s(v1[0], v1[1]); w.w = cvtpk_s(v1[2], v1[3]);
                    *(u32x4*)(rowp + bj * HALF) = w; } }
    }
};
struct EpiSwiglu {
    static constexpr bool PERM = true;
    bf16_t* O; int ldc;
    __device__ __forceinline__ void operator()(const f32x4 (&acc)[2][2][4][2], const Unit& u, int wr, int wc, int fr, int fq) const {
        const int row0 = u.pm * BM + wr * 64 + fr, col0 = u.pn * HALF + wc * 32 + 8 * fq;
#pragma unroll
        for (int ai = 0; ai < 2; ++ai)
#pragma unroll
            for (int m = 0; m < 4; ++m) { bf16_t* rowp = O + (size_t)(row0 + ai * HALF + m * 16) * ldc + col0;
                float h[8];
#pragma unroll
                for (int n = 0; n < 2; ++n)
#pragma unroll
                    for (int e = 0; e < 4; ++e) { const float g = acc[ai][0][m][n][e], up = acc[ai][1][m][n][e];
                        h[n * 4 + e] = g * __builtin_amdgcn_rcpf(1.0f + __builtin_amdgcn_exp2f(-LOG2E * g)) * up; }
                u32x4 w; w.x = cvt_pk_bf16(h[0], h[1]); w.y = cvt_pk_bf16(h[2], h[3]); w.z = cvt_pk_bf16(h[4], h[5]); w.w = cvt_pk_bf16(h[6], h[7]);
                *(u32x4*)rowp = w; }
    }
};
struct EpiQKV {
    static constexpr bool PERM = false;
    bf16_t* O; int ldc; int n_rope_tiles, n_q_tiles, n_lat_tiles; const LAS float* cosT; const LAS float* sinT;
    __device__ __forceinline__ void operator()(const f32x4 (&acc)[2][2][4][2], const Unit& u, int wr, int wc, int fr, int fq) const {
        const int row0 = u.pm * BM + wr * 64 + fr, col0 = u.pn * BM + wc * 32 + 4 * fq;
        const bool rope = (u.pn < n_rope_tiles) && (u.pm < n_lat_tiles);
        const float sc = (u.pn < n_q_tiles) ? QSCALE : 1.0f;
#pragma unroll
        for (int ai = 0; ai < 2; ++ai)
#pragma unroll
            for (int m = 0; m < 4; ++m) { const int row = row0 + ai * HALF + m * 16; bf16_t* rowp = O + (size_t)row * ldc + col0;
                f32x4 cs = (f32x4){1.f, 1.f, 1.f, 1.f}, sn = (f32x4){0.f, 0.f, 0.f, 0.f};
                if (rope) { const int t = row & (SEQ - 1); const int pos = (wc & 1) ? (t & 63) : (t >> 6);
                    cs = *(const LAS f32x4*)(cosT + pos * 16 + 4 * fq); sn = *(const LAS f32x4*)(sinT + pos * 16 + 4 * fq); }
#pragma unroll
                for (int bj = 0; bj < 2; ++bj) { const f32x4 x1 = acc[ai][bj][m][0], x2 = acc[ai][bj][m][1];
                    const f32x4 o1 = (x1 * cs - x2 * sn) * sc, o2 = (x2 * cs + x1 * sn) * sc;
                    const unsigned w1x = cvtpk_s(o1[0], o1[1]), w1y = cvtpk_s(o1[2], o1[3]), w2x = cvtpk_s(o2[0], o2[1]), w2y = cvtpk_s(o2[2], o2[3]);
                    const auto s0 = __builtin_amdgcn_permlane16_swap(w1x, w2x, false, false), s1 = __builtin_amdgcn_permlane16_swap(w1y, w2y, false, false);
                    u32x4 w; w.x = s0[0]; w.y = s1[0]; w.z = s0[1]; w.w = s1[1];
                    *(u32x4*)(rowp - 4 * fq + bj * HALF + ((fq & 1) << 4) + ((fq >> 1) << 3)) = w; } }
    }
};

constexpr int GATHER_MAX_UNITS = 17;
template <class Epi, class Sched, bool GATHER = false>
__device__ __forceinline__ void gemm_phase(LAS unsigned char* lds, const Gemm g, const Sched& S, const Epi& E, const unsigned short* ridx = nullptr) {
    const int tid = fresh_tid(), wid = __builtin_amdgcn_readfirstlane(tid >> 6), lane = tid & 63, wr = wid >> 2, wc = wid & 3, fr = lane & 15, fq = lane >> 4;
    const int K = g.K;
    unsigned voffA[2], voffB[2];
#pragma unroll
    for (int i = 0; i < 2; ++i) { int R, C; stage_rc(tid * 16 + i * 8192, R, C); const int Rb = Epi::PERM ? ((R & ~31) + perm32(R & 31)) : R;
        voffA[i] = (unsigned)(R * K + C) * 2u; voffB[i] = (unsigned)(Rb * K + C) * 2u; }
    const size_t kstep = (size_t)(BK * 2);
    const size_t hstep = (size_t)HALF * K * 2;
    const size_t tstep = 2 * hstep;
    const unsigned ldsw = (unsigned)wid * 1024u;
    const int aoff = lds_byte(wr * 64 + fr, fq * 8), boff = lds_byte(wc * 32 + fr, fq * 8), aoff1 = aoff ^ 64, boff1 = boff ^ 64;
#define PG8_SA(b, h) (((b) * 2 + (h)) * HTB)
#define PG8_SB(b, h) ((4 + (b) * 2 + (h)) * HTB)
#define PG8_STAGE(bufoff, gbase, voff) do { _Pragma("unroll") for (int _i = 0; _i < 2; ++_i) \
        __builtin_amdgcn_global_load_lds((const unsigned*)((const char*)(gbase) + (voff)[_i]), (LAS unsigned*)(lds + (bufoff) + ldsw + _i * 8192), 16, 0, 0); } while (0)
#define PG8_LDA(dst, b, h) do { _Pragma("unroll") for (int m = 0; m < 4; ++m) _Pragma("unroll") for (int k = 0; k < 2; ++k) dst[m][k] = *(const LAS bf16x8*)(lds + PG8_SA(b, h) + (k ? aoff1 : aoff) + m * 2048); } while (0)
#define PG8_LDB(dst, b, h) do { _Pragma("unroll") for (int n = 0; n < 2; ++n) _Pragma("unroll") for (int k = 0; k < 2; ++k) dst[n][k] = *(const LAS bf16x8*)(lds + PG8_SB(b, h) + (k ? boff1 : boff) + n * 2048); } while (0)
#define PG8_MMA(ai, bj, At, Bt) do { __builtin_amdgcn_s_setprio(1); _Pragma("unroll") for (int m = 0; m < 4; ++m) _Pragma("unroll") for (int n = 0; n < 2; ++n) _Pragma("unroll") for (int k = 0; k < 2; ++k) \
        acc[ai][bj][m][n] = __builtin_amdgcn_mfma_f32_16x16x32_bf16(Bt[n][k], At[m][k], acc[ai][bj][m][n], 0, 0, 0); __builtin_amdgcn_s_setprio(0); } while (0)
#define PG8_WAIT_V(n) asm volatile("s_waitcnt vmcnt(" #n ")" ::: "memory")
#define PG8_WAIT_L(n) asm volatile("s_waitcnt lgkmcnt(" #n ")" ::: "memory")
#define PG8_BAR __builtin_amdgcn_s_barrier()
#define PG8_SCHED __builtin_amdgcn_sched_barrier(0)
    Unit cur, nxt; int ui = 0;
    if (!S.next(0, cur)) return;
    unsigned cv[2][2], nv[2][2];
    LAS unsigned short* gtab = (LAS unsigned short*)(lds + STAGE_BYTES);
    int gR[2], gC2[2];
    if constexpr (GATHER) {
#pragma unroll
        for (int i = 0; i < 2; ++i) { int R, C; stage_rc(tid * 16 + i * 8192, R, C); gR[i] = R; gC2[i] = C * 2; }
        { Unit u; for (int i = 0; i < GATHER_MAX_UNITS && S.next(i, u); ++i) if (tid < 256) gtab[i * 256 + tid] = ridx[u.pm * 256 + tid]; }
        __syncthreads();
#pragma unroll
        for (int h = 0; h < 2; ++h)
#pragma unroll
            for (int i = 0; i < 2; ++i) cv[h][i] = (unsigned)gtab[h * 128 + gR[i]] * (unsigned)(K * 2) + (unsigned)gC2[i];
    }
    const bool gdg = DIAG_SEL && g.diag != nullptr && wid == DIAG_WAVE;
    unsigned long long g0 = 0, gep = 0, gc0 = 0;
    if (gdg) { g0 = __builtin_amdgcn_s_memrealtime(); gc0 = __builtin_amdgcn_s_memtime(); }
    f32x4 acc[2][2][4][2];
#pragma unroll
    for (int a = 0; a < 2; ++a)
#pragma unroll
        for (int b = 0; b < 2; ++b)
#pragma unroll
            for (int m = 0; m < 4; ++m)
#pragma unroll
                for (int n = 0; n < 2; ++n) acc[a][b][m][n] = (f32x4){0.f, 0.f, 0.f, 0.f};
    bf16x8 At[4][2], B0[2][2], B1[2][2];
#define PG8_STAGE_A(bufoff, p, h) do { if constexpr (GATHER) { PG8_STAGE(bufoff, p, cv[h]); } else { PG8_STAGE(bufoff, (p) + (h) * hstep, voffA); } } while (0)
    const char* cA = (const char*)g.A + (GATHER ? (size_t)0 : (size_t)cur.pm * tstep) + (size_t)cur.kt0 * kstep; const char* cB = (const char*)g.Bt + (size_t)cur.pb * tstep + (size_t)cur.kt0 * kstep;
    PG8_STAGE(PG8_SB(0, 0), cB, voffB); PG8_STAGE(PG8_SB(0, 1), cB + hstep, voffB); PG8_STAGE_A(PG8_SA(0, 0), cA, 0); PG8_STAGE_A(PG8_SA(0, 1), cA, 1);
    if (wr == 1) PG8_BAR;
    PG8_WAIT_V(2); PG8_BAR;
    PG8_STAGE(PG8_SB(1, 0), cB + kstep, voffB); PG8_STAGE_A(PG8_SA(1, 0), cA + kstep, 0); PG8_STAGE(PG8_SB(1, 1), cB + hstep + kstep, voffB);
    PG8_WAIT_V(6); PG8_BAR;
    for (;;) {
        const bool has_next = S.next(ui + 1, nxt);
        const char* nA = has_next ? (const char*)g.A + (GATHER ? (size_t)0 : (size_t)nxt.pm * tstep) + (size_t)nxt.kt0 * kstep : cA; const char* nB = has_next ? (const char*)g.Bt + (size_t)nxt.pb * tstep + (size_t)nxt.kt0 * kstep : cB;
        if constexpr (GATHER) {
#pragma unroll
            for (int h = 0; h < 2; ++h)
#pragma unroll
                for (int i = 0; i < 2; ++i) nv[h][i] = has_next ? (unsigned)gtab[(ui + 1) * 256 + h * 128 + gR[i]] * (unsigned)(K * 2) + (unsigned)gC2[i] : cv[h][i];
        }
        const int nt = cur.nkt;
        for (int t = 0; t < nt; t += 2) {
            const bool last = (t == nt - 2);
            const char* a1 = cA + (size_t)(t + 1) * kstep;
            const char* a2 = last ? nA : cA + (size_t)(t + 2) * kstep; const char* b2 = last ? nB : cB + (size_t)(t + 2) * kstep;
            const char* a3 = a2 + kstep; const char* b3 = b2 + kstep;
            PG8_LDB(B0, 0, 0); PG8_LDB(B1, 0, 1); PG8_SCHED; PG8_LDA(At, 0, 0); PG8_STAGE_A(PG8_SA(1, 1), a1, 1);
            if constexpr (GATHER) { if (last) {
#pragma unroll
                for (int h = 0; h < 2; ++h)
#pragma unroll
                    for (int i = 0; i < 2; ++i) cv[h][i] = nv[h][i]; } }
            PG8_WAIT_V(8); PG8_WAIT_L(0); PG8_BAR; PG8_MMA(0, 0, At, B0); PG8_MMA(0, 1, At, B1); PG8_BAR; PG8_SCHED;
            PG8_LDA(At, 0, 1); PG8_STAGE(PG8_SB(0, 0), b2, voffB); PG8_STAGE(PG8_SB(0, 1), b2 + hstep, voffB); PG8_STAGE_A(PG8_SA(0, 0), a2, 0);
            PG8_WAIT_V(8); PG8_WAIT_L(0); PG8_BAR; PG8_MMA(1, 0, At, B0); PG8_MMA(1, 1, At, B1); PG8_BAR; PG8_SCHED;
            PG8_LDB(B0, 1, 0); PG8_LDB(B1, 1, 1); PG8_SCHED; PG8_LDA(At, 1, 0); PG8_STAGE_A(PG8_SA(0, 1), a2, 1);
            PG8_WAIT_V(8); PG8_WAIT_L(0); PG8_BAR; PG8_MMA(0, 0, At, B0); PG8_MMA(0, 1, At, B1); PG8_BAR; PG8_SCHED;
            PG8_LDA(At, 1, 1); PG8_STAGE(PG8_SB(1, 0), b3, voffB); PG8_STAGE(PG8_SB(1, 1), b3 + hstep, voffB); PG8_STAGE_A(PG8_SA(1, 0), a3, 0);
            PG8_WAIT_V(8); PG8_WAIT_L(0); PG8_BAR; PG8_MMA(1, 0, At, B0); PG8_MMA(1, 1, At, B1); PG8_BAR; PG8_SCHED;
        }
        if (wr == 0) PG8_BAR;
        unsigned long long ge0 = 0; if (gdg) ge0 = __builtin_amdgcn_s_memrealtime();
        E(acc, cur, wr, wc, fr, fq);
        if (gdg) { asm volatile("" ::: "memory"); gep += __builtin_amdgcn_s_memrealtime() - ge0; }
        if (!has_next) break;
#pragma unroll
        for (int a = 0; a < 2; ++a)
#pragma unroll
            for (int b = 0; b < 2; ++b)
#pragma unroll
                for (int m = 0; m < 4; ++m)
#pragma unroll
                    for (int n = 0; n < 2; ++n) acc[a][b][m][n] = (f32x4){0.f, 0.f, 0.f, 0.f};
        cur = nxt; cA = nA; cB = nB; ++ui;
        if (wr == 1) PG8_BAR;
    }
    PG8_WAIT_V(0);
    PG8_BAR;
    if (gdg && lane == 0) { const unsigned long long g1 = __builtin_amdgcn_s_memrealtime(), gc1 = __builtin_amdgcn_s_memtime(); g.diag[8] = (unsigned)(g1 - g0); g.diag[9] = (unsigned)gep; g.diag[10] = (unsigned)((gc1 - gc0) >> 8); g.diag[11] = (unsigned)(ui + 1) * 500u; }
#undef PG8_SA
#undef PG8_SB
#undef PG8_STAGE
#undef PG8_STAGE_A
#undef PG8_LDA
#undef PG8_LDB
#undef PG8_MMA
#undef PG8_WAIT_V
#undef PG8_WAIT_L
#undef PG8_BAR
#undef PG8_SCHED
}
}

namespace att {
typedef LAS const char* lcptr;
typedef short v4i16_t __attribute__((ext_vector_type(4)));
constexpr int KBUF = 0, KS = 16384, NKS = 4, VBUF = 65536, VS = 16384, NVS = 3, WSF = 114688, XCH = 32768;
constexpr float THR = 8.0f;
__device__ __forceinline__ int crow(int r, int hi) { return (r & 3) + 8 * (r >> 2) + 4 * hi; }
__device__ __forceinline__ s16x4 vtr(lcptr p) { return __builtin_bit_cast(s16x4, __builtin_amdgcn_ds_read_tr16_b64_v4i16((LAS v4i16_t*)p)); }

struct UnitD {
    int qrow0;
    int qcol, kcol, vcol;
    int n1, base1, n2, base2;
    int kp0;
    int qp0;
    int masked;
    float sink2;
    int use_sink;
    int ocol;
    unsigned* diag;
};

__device__ __forceinline__ void glds16(const void* gsrc, unsigned lds_dst) { unsigned keep;
    asm volatile("s_mov_b32 %0, m0\n\ts_mov_b32 m0, %2\n\ts_nop 0\n\tglobal_load_lds_dwordx4 %1, off\n\ts_mov_b32 m0, %0" : "=&s"(keep) : "v"(gsrc), "s"(lds_dst) : "memory"); }
template <bool TB>
__device__ __forceinline__ void dma_k(const bf16_t* QKV, int NQ, int rowbase, int kcol, unsigned kbuf, int wid, int lane) {
#pragma unroll
    for (int i = 0; i < (TB ? 2 : 1); ++i) { const int pc = wid + 8 * i, head = pc >> 3, j = pc & 7;
        const int row = 8 * j + (lane >> 3), chunk = (lane & 7) ^ ((row >> 1) & 7);
        const bf16_t* src = QKV + (size_t)(rowbase + row) * NQ + kcol + head * 64 + chunk * 8;
        glds16(src, (unsigned)__builtin_amdgcn_readfirstlane(kbuf + head * 8192 + j * 1024)); }
}
template <bool TB>
__device__ __forceinline__ void dma_v(const bf16_t* QKV, int NQ, int rowbase, int vcol, unsigned vbuf, int wid, int lane) {
#pragma unroll
    for (int i = 0; i < (TB ? 2 : 1); ++i) { const int pv = wid + 8 * i, cb = pv >> 3, kg = pv & 7;
        const int key = 8 * kg + (lane >> 3), q = lane & 7, hs = (q >> 2) ^ ((key >> 1) & 1);
        const bf16_t* src = QKV + (size_t)(rowbase + key) * NQ + vcol + cb * 64 + hs * 32 + (q & 3) * 8;
        glds16(src, (unsigned)__builtin_amdgcn_readfirstlane(vbuf + pv * 1024)); }
}

template <bool TB>
__device__ __forceinline__ void unit_prologue_dma(const bf16_t* QKV, int NQ, const UnitD& X, unsigned lds0, int wid, int lane) {
    const int NTx = X.n1 + X.n2;
    const int rb1 = 1 < X.n1 ? X.base1 + 64 : X.base2 + 64 * (1 - X.n1), rb2 = 2 < X.n1 ? X.base1 + 128 : X.base2 + 64 * (2 - X.n1);
    dma_k<TB>(QKV, NQ, X.base1, X.kcol, lds0 + KBUF, wid, lane);
    dma_v<TB>(QKV, NQ, X.base1, X.vcol, lds0 + VBUF, wid, lane);
    if (NTx > 1) { dma_k<TB>(QKV, NQ, rb1, X.kcol, lds0 + KBUF + KS, wid, lane); dma_v<TB>(QKV, NQ, rb1, X.vcol, lds0 + VBUF + VS, wid, lane); }
    if (NTx > 2) dma_k<TB>(QKV, NQ, rb2, X.kcol, lds0 + KBUF + 2 * KS, wid, lane);
}
template <bool TB, bool LATE>
__device__ __forceinline__ void attn_unit_body(LAS unsigned char* lds, const bf16_t* QKV, int NQ, bf16_t* O, const UnitD& U, const UnitD& Un, bool has_next, bool prefetched, float lam, float post_scale, const float* subln) {
    constexpr int NDB = TB ? 4 : 2;
    const int tid = fresh_tid(), lane = tid & 63, r32 = lane & 31, hi = lane >> 5; const int wid = __builtin_amdgcn_readfirstlane(tid >> 6);
    const int sub = wid >> 2, w4 = wid & 3;
    LAS float* wsf = (LAS float*)(lds + WSF) + wid * 64;
    const int NT = U.n1 + U.n2;
#define ATT_ROWBASE(tt) ((tt) < U.n1 ? U.base1 + 64 * (tt) : U.base2 + 64 * ((tt) - U.n1))
    const unsigned lds0 = (unsigned)(uintptr_t)lds;
    const bool dg = false;
    unsigned long long dt0 = 0, dt1 = 0, dt2 = 0, dwait = 0, dA = 0, dB = 0, dsa = 0;
    if (dg) dt0 = __builtin_amdgcn_s_memrealtime();
    if (!prefetched) unit_prologue_dma<TB>(QKV, NQ, U, lds0, wid, lane);
    bf16x8 qr[4];
    { const bf16_t* qp = QKV + (size_t)(U.qrow0 + w4 * 32 + r32) * NQ + U.qcol + hi * 8;
#pragma unroll
      for (int d0 = 0; d0 < 4; ++d0) qr[d0] = *(const bf16x8*)(qp + d0 * 16); }
    f32x16 o[NDB];
#pragma unroll
    for (int d = 0; d < NDB; ++d) o[d] = f32x16{};
    f32x16 negm = f32x16{}; float mhat = 0.f, l_reg = 0.f;
    const int qpos = U.qp0 + r32;
    VM_WAIT(); __builtin_amdgcn_s_barrier(); asm volatile("" ::: "memory");
    asm volatile("" : "+v"(qr[0]), "+v"(qr[1]), "+v"(qr[2]), "+v"(qr[3]));
    int ks = 0, vs = 0;
#define ATT_SBAR() __builtin_amdgcn_sched_barrier(0)
#define ATT_KLOAD(slot) do { const lcptr kb_ = (lcptr)(lds + KBUF + (slot) * KS + (TB ? sub * 8192 : 0)) + r32 * 128; const int kx_ = ((r32 >> 1) & 7) ^ hi; \
        _Pragma("unroll") for (int i_ = 0; i_ < 8; ++i_) kf[i_] = *(const LAS bf16x8*)(kb_ + (((2 * (i_ >> 1)) ^ kx_) << 4) + (i_ & 1) * 4096); } while (0)
#define ATT_VLOAD(LO, HI, d) do { const lcptr vb_ = ((d) & 1) ? vp1 : vp0; _Pragma("unroll") for (int k4 = 0; k4 < 4; ++k4) { LO[k4] = vtr(vb_ + ((d) >> 1) * 8192 + k4 * 2048); HI[k4] = vtr(vb_ + ((d) >> 1) * 8192 + k4 * 2048 + 1024); } } while (0)
#define ATT_VMMA(LO, HI, d) do { _Pragma("unroll") for (int k4 = 0; k4 < 4; ++k4) o[d] = __builtin_amdgcn_mfma_f32_32x32x16_bf16(__builtin_bit_cast(bf16x8, pw[k4]), \
        ((bf16x8){LO[k4][0], LO[k4][1], LO[k4][2], LO[k4][3], HI[k4][0], HI[k4][1], HI[k4][2], HI[k4][3]}), o[d], 0, 0, 0); } while (0)
    bf16x8 kf[8];
    f32x16 p0, p1; u32x4 pw[4];
    float one_ = 1.0f; asm volatile("" : "+v"(one_));
#define ATT_QK() do { p0 = __builtin_amdgcn_mfma_f32_32x32x16_bf16(kf[0], qr[0], negm, 0, 0, 0); p1 = __builtin_amdgcn_mfma_f32_32x32x16_bf16(kf[1], qr[0], negm, 0, 0, 0); \
        _Pragma("unroll") for (int d0 = 1; d0 < 4; ++d0) { p0 = __builtin_amdgcn_mfma_f32_32x32x16_bf16(kf[2 * d0], qr[d0], p0, 0, 0, 0); p1 = __builtin_amdgcn_mfma_f32_32x32x16_bf16(kf[2 * d0 + 1], qr[d0], p1, 0, 0, 0); } } while (0)
#define ATT_SOFTMAX(tt) do { \
        if (!TB) { if (U.masked && (tt) >= U.n1) { const int dl0 = U.kp0 + 64 * ((tt) - U.n1) + 4 * hi - qpos; \
            _Pragma("unroll") for (int r = 0; r < 16; ++r) { const int dlt = dl0 + (r & 3) + 8 * (r >> 2); \
                if (dlt > 128 || dlt < -128) p0[r] = -1e30f; if (dlt + 32 > 128 || dlt + 32 < -128) p1[r] = -1e30f; } } } \
        float rm; { float a = __builtin_fmaxf(__builtin_fmaxf(p0[0], p0[1]), p1[0]), b = __builtin_fmaxf(__builtin_fmaxf(p0[2], p0[3]), p1[1]); a = __builtin_fmaxf(__builtin_fmaxf(a, p1[2]), p1[3]); \
          _Pragma("unroll") for (int r = 4; r < 16; r += 4) { a = __builtin_fmaxf(__builtin_fmaxf(a, p0[r]), p0[r + 1]); b = __builtin_fmaxf(__builtin_fmaxf(b, p0[r + 2]), p0[r + 3]); a = __builtin_fmaxf(__builtin_fmaxf(a, p1[r]), p1[r + 1]); b = __builtin_fmaxf(__builtin_fmaxf(b, p1[r + 2]), p1[r + 3]); } \
          rm = __builtin_fmaxf(a, b); auto rr = __builtin_amdgcn_permlane32_swap(__float_as_uint(rm), __float_as_uint(rm), false, false); rm = __builtin_fmaxf(__uint_as_float(rr[0]), __uint_as_float(rr[1])); } \
        if ((tt) == 0) { mhat = rm; _Pragma("unroll") for (int r = 0; r < 16; ++r) { p0[r] -= rm; p1[r] -= rm; negm[r] = -mhat; } } \
        else if (__any(rm > THR)) { const float dl = __builtin_fmaxf(rm, 0.f); mhat += dl; \
            _Pragma("unroll") for (int r = 0; r < 16; ++r) { p0[r] -= dl; p1[r] -= dl; negm[r] = -mhat; } \
            const float f = __builtin_amdgcn_exp2f(-dl); l_reg *= f; if (hi == 0) wsf[r32] = f; LDS_WAIT(); \
            _Pragma("unroll") for (int r = 0; r < 16; ++r) { const float fr_ = wsf[crow(r, hi)]; _Pragma("unroll") for (int d = 0; d < NDB; ++d) o[d][r] *= fr_; } } \
          \
        _Pragma("unroll") for (int r = 0; r < 16; ++r) { p0[r] = __builtin_amdgcn_exp2f(p0[r]); p1[r] = __builtin_amdgcn_exp2f(p1[r]); l_reg = __builtin_fmaf(p0[r], one_, l_reg); l_reg = __builtin_fmaf(p1[r], one_, l_reg); } \
        _Pragma("unroll") for (int s = 0; s < 2; ++s) { pw[s] = (u32x4){cvtpk_s(p0[8 * s], p0[8 * s + 1]), cvtpk_s(p0[8 * s + 2], p0[8 * s + 3]), cvtpk_s(p0[8 * s + 4], p0[8 * s + 5]), cvtpk_s(p0[8 * s + 6], p0[8 * s + 7])}; \
            pw[2 + s] = (u32x4){cvtpk_s(p1[8 * s], p1[8 * s + 1]), cvtpk_s(p1[8 * s + 2], p1[8 * s + 3]), cvtpk_s(p1[8 * s + 4], p1[8 * s + 5]), cvtpk_s(p1[8 * s + 6], p1[8 * s + 7])}; } } while (0)
    if (!LATE) { ATT_KLOAD(0); ATT_QK(); ATT_SOFTMAX(0); }
    if (sub == 1) __builtin_amdgcn_s_setprio(1);
    for (int t = 0; t < NT; ++t) {
        VM_WAIT();
        __builtin_amdgcn_s_barrier(); asm volatile("" ::: "memory");
        if (t + 3 < NT) { const int k3 = (ks + 3) & 3; dma_k<TB>(QKV, NQ, ATT_ROWBASE(t + 3), U.kcol, lds0 + KBUF + k3 * KS, wid, lane); }
        if (t + 2 < NT) { int v2 = vs + 2; v2 = v2 >= 3 ? v2 - 3 : v2; dma_v<TB>(QKV, NQ, ATT_ROWBASE(t + 2), U.vcol, lds0 + VBUF + v2 * VS, wid, lane); }
        if (LATE) { ATT_KLOAD(ks); ATT_QK(); ATT_SBAR(); ATT_SOFTMAX(t); ATT_SBAR(); }
        const lcptr vp0 = (lcptr)(lds + VBUF + vs * VS) + ((lane >> 4) & 1) * 32 + (lane & 3) * 8 + (4 * hi + ((lane & 15) >> 2)) * 128 + ((lane >> 3) & 1) * 64;
        const lcptr vp1 = vp0 + 64 - ((lane >> 3) & 1) * 128;
        s16x4 va_lo[4], va_hi[4], vb_lo[4], vb_hi[4];
        const bool more = t + 1 < NT;
        ATT_SBAR();
        ATT_VLOAD(va_lo, va_hi, 0);
        ATT_VLOAD(vb_lo, vb_hi, 1);
        ATT_SBAR();
        ATT_VMMA(va_lo, va_hi, 0);
        if (TB) { ATT_SBAR(); ATT_VLOAD(va_lo, va_hi, NDB - 2); }
        else { ATT_SBAR(); if (!LATE && more) { const int k1 = (ks + 1) & 3; ATT_KLOAD(k1); } }
        ATT_SBAR();
        ATT_VMMA(vb_lo, vb_hi, 1);
        if (TB) { ATT_SBAR(); ATT_VLOAD(vb_lo, vb_hi, NDB - 1); ATT_SBAR(); ATT_VMMA(va_lo, va_hi, NDB - 2); ATT_SBAR(); if (!LATE && more) { const int k1 = (ks + 1) & 3; ATT_KLOAD(k1); } ATT_SBAR(); ATT_VMMA(vb_lo, vb_hi, NDB - 1); }
        ATT_SBAR();
        if (!LATE && more) {
            ATT_QK();
            ATT_SBAR();
            ATT_SOFTMAX(t + 1);
        }
        ks = (ks + 1) & 3; vs = vs == 2 ? 0 : vs + 1;
    }
    __builtin_amdgcn_s_setprio(0);
#undef ATT_QK
#undef ATT_SOFTMAX
#undef ATT_SBAR
#undef ATT_KLOAD
#undef ATT_VLOAD
#undef ATT_VMMA
#undef ATT_SEAM
#undef ATT_ROWBASE
    { auto rr = __builtin_amdgcn_permlane32_swap(__float_as_uint(l_reg), __float_as_uint(l_reg), false, false); l_reg = __uint_as_float(rr[0]) + __uint_as_float(rr[1]); }
    if (!TB) { if (U.use_sink) l_reg += __builtin_amdgcn_exp2f(U.sink2 - mhat); }
    if (hi == 0) wsf[32 + r32] = l_reg;
    LDS_WAIT();
    float rli[16];
#pragma unroll
    for (int r = 0; r < 16; ++r) rli[r] = 1.0f / wsf[32 + crow(r, hi)];
    const int orow0 = U.qrow0 + w4 * 32;
    if (!TB) {
        __builtin_amdgcn_s_barrier(); asm volatile("" ::: "memory");
        if (has_next) unit_prologue_dma<TB>(QKV, NQ, Un, lds0, wid, lane);
        LAS unsigned short* stg = (LAS unsigned short*)(lds + (sub == 0 ? KBUF + 3 * KS : VBUF + 2 * VS)) + w4 * 2048;
#pragma unroll
        for (int r = 0; r < 16; ++r) {
#pragma unroll
            for (int d = 0; d < NDB; ++d) stg[crow(r, hi) * 64 + d * 32 + r32] = (unsigned short)(cvt_pk_bf16(o[d][r] * rli[r], 0.f) & 0xffffu); }
        LDS_WAIT();
#pragma unroll
        for (int i = 0; i < 4; ++i) { const int row = i * 8 + (lane >> 3), ch = lane & 7; const u32x4 v = *(const LAS u32x4*)(stg + row * 64 + ch * 8);
            *(u32x4*)(O + (size_t)(orow0 + row) * D + U.ocol + ch * 8) = v; }
    } else {
        LAS float* X = (LAS float*)(lds + XCH) + (size_t)w4 * 2048 + lane;
        __builtin_amdgcn_s_barrier(); asm volatile("" ::: "memory");
#pragma unroll
        for (int rd = 0; rd < 2; ++rd) {
            if (sub == 1) {
#pragma unroll
                for (int d = 0; d < 2; ++d)
#pragma unroll
                    for (int r = 0; r < 16; ++r) X[(d * 16 + r) * 64] = o[2 * rd + d][r] * rli[r];
            }
            LDS_WAIT(); __builtin_amdgcn_s_barrier(); asm volatile("" ::: "memory");
            if (sub == 0) {
#pragma unroll
                for (int d = 0; d < 2; ++d)
#pragma unroll
                    for (int r = 0; r < 16; ++r) o[2 * rd + d][r] = o[2 * rd + d][r] * rli[r] - lam * X[(d * 16 + r) * 64];
            }
            LDS_WAIT(); __builtin_amdgcn_s_barrier(); asm volatile("" ::: "memory");
        }
        float gam[NDB];
#pragma unroll
        for (int d = 0; d < NDB; ++d) gam[d] = subln[d * 32 + r32] * post_scale;
        if (TB) asm volatile("" : "+v"(gam[0]), "+v"(gam[1]), "+v"(gam[NDB - 2]), "+v"(gam[NDB - 1]));
        if (has_next) unit_prologue_dma<TB>(QKV, NQ, Un, lds0, wid, lane);
        if (sub == 0) {
#pragma unroll
            for (int r = 0; r < 16; ++r) { float ss = 0.f;
#pragma unroll
                for (int d = 0; d < NDB; ++d) ss += o[d][r] * o[d][r];
                ss = half_allsum(ss);
                const float rs = __builtin_amdgcn_rsqf(ss * (1.0f / 128.0f) + RMS_EPS);
#pragma unroll
                for (int d = 0; d < NDB; ++d) o[d][r] *= rs * gam[d]; }
            LAS unsigned short* stg = (LAS unsigned short*)(lds + VBUF + 2 * VS) + w4 * 2048;
#pragma unroll
            for (int hf = 0; hf < 2; ++hf) {
#pragma unroll
                for (int r = 0; r < 16; ++r) {
#pragma unroll
                    for (int d = 0; d < 2; ++d) stg[crow(r, hi) * 64 + d * 32 + r32] = (unsigned short)(cvt_pk_bf16(o[2 * hf + d][r], 0.f) & 0xffffu); }
                LDS_WAIT();
#pragma unroll
                for (int i = 0; i < 4; ++i) { const int row = i * 8 + (lane >> 3), ch = lane & 7; const u32x4 v = *(const LAS u32x4*)(stg + row * 64 + ch * 8);
                    *(u32x4*)(O + (size_t)(orow0 + row) * D + U.ocol + hf * 64 + ch * 8) = v; }
                LDS_WAIT();
            }
        }
    }
}
template <bool TB>
__device__ __forceinline__ void attn_unit(LAS unsigned char* lds, const bf16_t* QKV, int NQ, bf16_t* O, const UnitD& U, const UnitD& Un, bool has_next, bool prefetched, float lam, float post_scale, const float* subln) {
    const int wid = __builtin_amdgcn_readfirstlane(fresh_tid() >> 6);
    if (wid < 4) attn_unit_body<TB, false>(lds, QKV, NQ, O, U, Un, has_next, prefetched, lam, post_scale, subln); else attn_unit_body<TB, true>(lds, QKV, NQ, O, U, Un, has_next, prefetched, lam, post_scale, subln);
}
}

#define XB_TMO      128
#define XB_XCNT(j)  (256  + 64 * (j))
#define XB_XSUB(j)  (1280 + 64 * (j))
#define XB_XGEN(j)  (2304 + 64 * (j))
#define XB_TOP      3328
#define XB_TOPGEN   3392
#define XCD_BAR_WORDS 3456
#define XB_SPIN_CAP (1u << 18)

__device__ __forceinline__ unsigned xb_ld(unsigned* p)              { return __hip_atomic_load(p, __ATOMIC_RELAXED, __HIP_MEMORY_SCOPE_AGENT); }
__device__ __forceinline__ unsigned xb_add(unsigned* p, unsigned v) { return __hip_atomic_fetch_add(p, v, __ATOMIC_RELAXED, __HIP_MEMORY_SCOPE_AGENT); }
__device__ __forceinline__ unsigned xb_xcc_id() { return (unsigned)__builtin_amdgcn_s_getreg((3 << 11) | 20) & 0xFu; }
#define XB_SPIN(cond, bar) do { unsigned _sp = 0; while (cond) { __builtin_amdgcn_s_sleep(1); \
    if ((++_sp & 255u) == 0u) { if (xb_ld(&(bar)[XB_TMO])) break; if (_sp > XB_SPIN_CAP) { atomicAdd(&(bar)[XB_TMO], 1u); break; } } } } while (0)

struct XcdBarrier { unsigned* bar; unsigned x; volatile LAS unsigned* st; };

__device__ __forceinline__ XcdBarrier xcd_barrier_post(unsigned* bar, volatile LAS unsigned* st) {
    XcdBarrier b; b.bar = bar; b.x = xb_xcc_id(); b.st = st;
    if (threadIdx.x == 0) (void)xb_add(&bar[XB_XCNT(b.x)], 1u);
    return b;
}
__device__ __forceinline__ void xcd_barrier_complete(unsigned* bar, unsigned x, unsigned& nloc, unsigned& nx) {
    const unsigned G = gridDim.x * gridDim.y * gridDim.z;
    unsigned sum, cnt, mine, sp = 0u;
    for (;;) {
        sum = 0u; cnt = 0u; mine = 0u;
#pragma unroll
        for (unsigned j = 0; j < 16; ++j) { const unsigned c = xb_ld(&bar[XB_XCNT(j)]); sum += c; cnt += (c > 0u) ? 1u : 0u; mine = (j == x) ? c : mine; }
        if (sum == G) break;
        __builtin_amdgcn_s_sleep(1);
        if ((++sp & 255u) == 0u) { if (xb_ld(&bar[XB_TMO])) break; if (sp > XB_SPIN_CAP) { atomicAdd(&bar[XB_TMO], 1u); break; } }
    }
    nloc = mine > 0u ? mine : 1u; nx = cnt > 0u ? cnt : 1u;
}
__device__ __forceinline__ void xcd_barrier(const XcdBarrier& b) {
    asm volatile("s_waitcnt vmcnt(0)" ::: "memory");
    __syncthreads();
    if (threadIdx.x == 0) {
        unsigned* bar = b.bar;
        __builtin_amdgcn_s_waitcnt(0);
        unsigned nloc = b.st[0], nx = b.st[1];
        if (nloc == 0u) { xcd_barrier_complete(bar, b.x, nloc, nx); b.st[0] = nloc; b.st[1] = nx; }
        const unsigned old = xb_add(&bar[XB_XSUB(b.x)], 1u);
        const unsigned gen = old / nloc;
        if (old + 1u == (gen + 1u) * nloc) {
            __builtin_amdgcn_fence(__ATOMIC_RELEASE, "agent");
            asm volatile("s_waitcnt vmcnt(0)" ::: "memory");
            (void)xb_add(&bar[XB_TOP], 1u);
        }
        const unsigned target = (gen + 1u) * nx;
        XB_SPIN(xb_ld(&bar[XB_TOP]) < target, bar);
        __builtin_amdgcn_fence(__ATOMIC_ACQUIRE, "agent");
        asm volatile("s_waitcnt vmcnt(0)" ::: "memory");
    }
    __syncthreads();
}

struct Args {
    const float* x; const float* c; const float* ctx; const float* c_ctx; const float* w_mod; const float* b_mod; const float* ln_g; const float* ln_b;
    const float* a_w_qkv; const float* a_sink; const float* a_w_o; const float* b_w_qkv; const float* lq1; const float* lk1; const float* lq2; const float* lk2;
    const float* subln; const float* b_w_o; const float* ff_g; const float* ff_u; const float* ff_d; const float* moe_r; const float* moe_g; const float* moe_u; const float* moe_d;
    float* out; unsigned char* ws; int ph_lo, ph_hi;
};

__device__ __forceinline__ void transpose_item(const float* W, int K, int N, bf16_t* WT, int drow0, LAS float* scr, int k0, int n0, int lane) {
#pragma unroll 8
    for (int i = 0; i < 32; ++i) { const int kk = 2 * i + (lane >> 5); scr[kk * 33 + (lane & 31)] = W[(size_t)(k0 + kk) * N + n0 + (lane & 31)]; }
    LDS_WAIT(); asm volatile("" ::: "memory");
    const int c = lane & 7;
#pragma unroll
    for (int j = 0; j < 4; ++j) { const int n = (lane >> 3) + 8 * j; const LAS float* s = scr + (8 * c) * 33 + n;
        u32x4 o; o.x = cvt_pk_bf16(s[0 * 33], s[1 * 33]); o.y = cvt_pk_bf16(s[2 * 33], s[3 * 33]); o.z = cvt_pk_bf16(s[4 * 33], s[5 * 33]); o.w = cvt_pk_bf16(s[6 * 33], s[7 * 33]);
        *(u32x4*)(WT + (size_t)(drow0 + n) * K + k0 + 8 * c) = o; }
    LDS_WAIT(); asm volatile("" ::: "memory");
}
__device__ __forceinline__ void convert_mats(const float* src, int K, int N, int nmat, bf16_t* dst, int mode, LAS float* scr, int gw, int NGW, int& rot, int lane) {
    const int nnb = N / 32, ipm = (K / 64) * nnb, total = nmat * ipm;
    const size_t dstride = (size_t)(mode ? 2 * N : N) * K;
    int start = gw - rot; if (start < 0) start += NGW;
    for (int it = start; it < total; it += NGW) {
        const int mat = it / ipm, r = it - mat * ipm, kb = r / nnb, nb = r - kb * nnb, n0 = nb * 32;
        const int drow0 = mode == 0 ? n0 : ((n0 >> 7) * 256 + (n0 & 127) + (mode == 2 ? 128 : 0));
        transpose_item(src + (size_t)mat * K * N, K, N, dst + (size_t)mat * dstride, drow0, scr, kb * 64, n0, lane);
    }
    rot = (rot + total) % NGW;
}

struct RowP {
    const bf16_t* xin_b;
    bf16_t* xout_b;
    float* xout_f;
    const bf16_t* F;
    const bf16_t* Fp;
    const float* mod_gate; const float* lg; const float* lb;
    const float* mod_sc; const float* mod_sh;
    bf16_t* H;
    const unsigned* tok;
    int two;
    const float* wr;
    unsigned* cnt;
    unsigned* tokw;
};

__device__ __forceinline__ float router_reduce(const float (&lg)[8], int lane) {
    float s[4], t[2];
#pragma unroll
    for (int k = 0; k < 4; ++k) { auto r = __builtin_amdgcn_permlane32_swap(__float_as_uint(lg[k]), __float_as_uint(lg[k + 4]), false, false); s[k] = __uint_as_float(r[0]) + __uint_as_float(r[1]); }
#pragma unroll
    for (int k = 0; k < 2; ++k) { auto r = __builtin_amdgcn_permlane16_swap(__float_as_uint(s[k]), __float_as_uint(s[k + 2]), false, false); t[k] = __uint_as_float(r[0]) + __uint_as_float(r[1]); }
    const float snd = (lane & 1) ? t[0] : t[1], kp = (lane & 1) ? t[1] : t[0];
    float u = kp + __int_as_float(__builtin_amdgcn_update_dpp(0, __float_as_int(snd), 0xB1, 0xF, 0xF, true));
    u = dpp_xadd<0x4E>(u); u = dpp_xadd<0x124>(u); u = dpp_xadd<0x128>(u);
    return u;
}
template <bool TWO, bool OUTF>
__device__ __forceinline__ void row_phase(const RowP& P, int row_lo, int nrows, LAS unsigned char* lds, int tid, int lane, int wave, int half_rows) {
    const int rpb = nrows / GRID, brow0 = row_lo + (int)blockIdx.x, nj = rpb >> 3;
#define CB(jj) (8 * lane + 512 * ((jj) >> 1) + 4 * ((jj) & 1))
#define UNPK_LO(w4) ((f32x4){bf_lo((w4).x), bf_hi((w4).x), bf_lo((w4).y), bf_hi((w4).y)})
#define UNPK_HI(w4) ((f32x4){bf_lo((w4).z), bf_hi((w4).z), bf_lo((w4).w), bf_hi((w4).w)})
    LAS f32x4* wrl = (LAS f32x4*)lds;
    LAS int* ebuf = (LAS int*)(lds + 32768);
    __syncthreads();
    if (P.wr) {
        for (int idx = tid; idx < 2048; idx += 512) { const int l = idx & 63, hh = (idx >> 6) & 1, e4 = (idx >> 7) & 3, j = idx >> 9; const int d = 8 * l + 512 * (j >> 1) + 4 * (j & 1) + e4;
            wrl[idx] = *(const f32x4*)(P.wr + (size_t)d * 8 + hh * 4); }
    }
    LAS f32x4* lgl = (LAS f32x4*)(lds + 40960);
    LAS f32x4* lbl = (LAS f32x4*)(lds + 45056);
    if (tid < 256) { const int l = tid & 63, j = tid >> 6; const int c = 8 * l + 512 * (j >> 1) + 4 * (j & 1); lgl[tid] = *(const f32x4*)(P.lg + c); lbl[tid] = *(const f32x4*)(P.lb + c); }
    __syncthreads();
    const bool dense18 = nj == 18;
#define JOF(i_) (dense18 ? ((i_) < 16 ? 16 * wave + (i_) : 128 + 2 * wave + ((i_) - 16)) : wave * nj + (i_))
    u32x4 a_x[2], a_fa[2], a_fb[2], b_x[2], b_fa[2], b_fb[2], pa[6], pb[6];
    int a_row, a_r1, a_r2, b_row, b_r1, b_r2; float a_w1, a_w2, b_w1, b_w2;
    f32x4 gv[4], scv[4], shv[4]; int m_cur = -1;
#define RP_FILL(S, i_) { \
        const int row_ = brow0 + GRID * JOF(i_); S##_row = row_; S##_r1 = row_; S##_r2 = row_; S##_w1 = 1.f; S##_w2 = 0.f; \
        if (TWO) { S##_r1 = (int)P.tok[TOK_SLOT + 2 * row_]; S##_r2 = (int)P.tok[TOK_SLOT + 2 * row_ + 1]; S##_w1 = __uint_as_float(P.tok[TOK_W + 2 * row_]); S##_w2 = __uint_as_float(P.tok[TOK_W + 2 * row_ + 1]); } \
        _Pragma("unroll") for (int p = 0; p < 2; ++p) { const int c8 = 8 * lane + 512 * p; \
            S##_x[p] = *(const u32x4*)(P.xin_b + (size_t)row_ * D + c8); S##_fa[p] = *(const u32x4*)(P.F + (size_t)S##_r1 * D + c8); \
            if (TWO) S##_fb[p] = *(const u32x4*)(P.F + (size_t)S##_r2 * D + c8); } }
#define RP_PART(S) { \
        if (S##_r1 >= SPLIT_ROW0) { _Pragma("unroll") for (int pp = 0; pp < 3; ++pp) _Pragma("unroll") for (int p = 0; p < 2; ++p) pa[2 * pp + p] = *(const u32x4*)(P.Fp + (size_t)pp * PART_STRIDE + (size_t)S##_r1 * D + 8 * lane + 512 * p); } \
        if (TWO && S##_r2 >= SPLIT_ROW0) { _Pragma("unroll") for (int pp = 0; pp < 3; ++pp) _Pragma("unroll") for (int p = 0; p < 2; ++p) pb[2 * pp + p] = *(const u32x4*)(P.Fp + (size_t)pp * PART_STRIDE + (size_t)S##_r2 * D + 8 * lane + 512 * p); } }
    u32x4 ox[2], oh[2]; f32x4 of[4]; int o_row = 0;
#define RP_STORE() { _Pragma("unroll") for (int p = 0; p < 2; ++p) { const int c8 = 8 * lane + 512 * p; \
            if (OUTF) { *(f32x4*)(P.xout_f + (size_t)o_row * D + c8) = of[2 * p]; *(f32x4*)(P.xout_f + (size_t)o_row * D + c8 + 4) = of[2 * p + 1]; } \
            else { *(u32x4*)(P.xout_b + (size_t)o_row * D + c8) = ox[p]; *(u32x4*)(P.H + (size_t)o_row * D + c8) = oh[p]; } } }
#define RP_BODY(S, T, i_) { \
        const int c_row = S##_row; const int c_mrow = c_row < ML ? (c_row >> 11) : 16; \
        if (c_mrow != m_cur) { m_cur = c_mrow; \
            _Pragma("unroll") for (int j = 0; j < 4; ++j) { gv[j] = *(const f32x4*)(P.mod_gate + (size_t)c_mrow * NMOD + CB(j)); \
                if (!OUTF) { scv[j] = *(const f32x4*)(P.mod_sc + (size_t)c_mrow * NMOD + CB(j)); shv[j] = *(const f32x4*)(P.mod_sh + (size_t)c_mrow * NMOD + CB(j)); } } } \
        f32x4 v[4]; \
        _Pragma("unroll") for (int p = 0; p < 2; ++p) { \
            v[2 * p] = UNPK_LO(S##_fa[p]) * S##_w1; v[2 * p + 1] = UNPK_HI(S##_fa[p]) * S##_w1; \
            if (TWO) { v[2 * p] += UNPK_LO(S##_fb[p]) * S##_w2; v[2 * p + 1] += UNPK_HI(S##_fb[p]) * S##_w2; } } \
        if (S##_r1 >= SPLIT_ROW0) { \
            _Pragma("unroll") for (int pp = 0; pp < 3; ++pp) _Pragma("unroll") for (int p = 0; p < 2; ++p) { v[2 * p] += UNPK_LO(pa[2 * pp + p]) * S##_w1; v[2 * p + 1] += UNPK_HI(pa[2 * pp + p]) * S##_w1; } } \
        if (TWO && S##_r2 >= SPLIT_ROW0) { \
            _Pragma("unroll") for (int pp = 0; pp < 3; ++pp) _Pragma("unroll") for (int p = 0; p < 2; ++p) { v[2 * p] += UNPK_LO(pb[2 * pp + p]) * S##_w2; v[2 * p + 1] += UNPK_HI(pb[2 * pp + p]) * S##_w2; } } \
        _Pragma("unroll") for (int j = 0; j < 4; ++j) { const f32x4 xj = (j & 1) ? UNPK_HI(S##_x[j >> 1]) : UNPK_LO(S##_x[j >> 1]); v[j] = xj * DN_ALPHA + (gv[j] + 1.0f) * v[j]; } \
        if ((i_) > 0) RP_STORE();                                    \
        { const int i2_ = (i_) + 2 < nj ? (i_) + 2 : nj - 1; RP_FILL(S, i2_); }     \
        if ((i_) + 1 < nj) RP_PART(T); \
        float s = 0.f; \
        _Pragma("unroll") for (int j = 0; j < 4; ++j) s += (v[j][0] + v[j][1]) + (v[j][2] + v[j][3]); \
        const float mean = wave_allsum(s) * (1.f / D); \
        float s2 = 0.f; \
        _Pragma("unroll") for (int j = 0; j < 4; ++j) { v[j] = v[j] - mean; s2 += (v[j][0] * v[j][0] + v[j][1] * v[j][1]) + (v[j][2] * v[j][2] + v[j][3] * v[j][3]); } \
        const float rstd = __builtin_amdgcn_rsqf(wave_allsum(s2) * (1.f / D) + LN_EPS); \
        o_row = c_row; \
        _Pragma("unroll") for (int p = 0; p < 2; ++p) { \
            const f32x4 xa = v[2 * p] * rstd * lgl[(2 * p) * 64 + lane] + lbl[(2 * p) * 64 + lane], xb = v[2 * p + 1] * rstd * lgl[(2 * p + 1) * 64 + lane] + lbl[(2 * p + 1) * 64 + lane]; \
            if (OUTF) { of[2 * p] = xa; of[2 * p + 1] = xb; } \
            else { \
                ox[p].x = cvt_pk_bf16(xa[0], xa[1]); ox[p].y = cvt_pk_bf16(xa[2], xa[3]); ox[p].z = cvt_pk_bf16(xb[0], xb[1]); ox[p].w = cvt_pk_bf16(xb[2], xb[3]); \
                const f32x4 ha = xa * (scv[2 * p] + 1.0f) + shv[2 * p], hb = xb * (scv[2 * p + 1] + 1.0f) + shv[2 * p + 1]; \
                oh[p].x = cvt_pk_bf16(ha[0], ha[1]); oh[p].y = cvt_pk_bf16(ha[2], ha[3]); oh[p].z = cvt_pk_bf16(hb[0], hb[1]); oh[p].w = cvt_pk_bf16(hb[2], hb[3]); \
                v[2 * p] = ha; v[2 * p + 1] = hb; } } \
        if (!OUTF && P.wr) { \
            float lg[8]; \
            _Pragma("unroll") for (int e = 0; e < 8; ++e) lg[e] = 0.f; \
            _Pragma("unroll") for (int j = 0; j < 4; ++j) _Pragma("unroll") for (int e4 = 0; e4 < 4; ++e4) { \
                const f32x4 wa = wrl[((j * 4 + e4) * 2 + 0) * 64 + lane], wb = wrl[((j * 4 + e4) * 2 + 1) * 64 + lane]; \
                _Pragma("unroll") for (int qq = 0; qq < 4; ++qq) { lg[qq] += v[j][e4] * wa[qq]; lg[4 + qq] += v[j][e4] * wb[qq]; } } \
            const float dd = router_reduce(lg, lane); \
            float lg8[8]; \
            _Pragma("unroll") for (int e = 0; e < 8; ++e) lg8[e] = __uint_as_float((unsigned)__builtin_amdgcn_readlane((int)__float_as_uint(dd), (e & 1) | (((e >> 1) & 1) << 4) | (((e >> 2) & 1) << 5))); \
            float v1 = lg8[0]; int e1 = 0; \
            _Pragma("unroll") for (int e = 1; e < 8; ++e) if (lg8[e] > v1) { v1 = lg8[e]; e1 = e; } \
            float v2 = -3.0e38f; int e2 = 0; \
            _Pragma("unroll") for (int e = 0; e < 8; ++e) if (e != e1 && lg8[e] > v2) { v2 = lg8[e]; e2 = e; } \
            const float ew = __expf(v2 - v1), wa_ = 1.0f / (1.0f + ew), wb_ = ew * wa_; \
            if (lane == 0) { ebuf[JOF(i_)] = e1 | (e2 << 8); P.tokw[TOK_E + c_row] = (unsigned)(e1 | (e2 << 8)); P.tokw[TOK_W + 2 * c_row] = __float_as_uint(wa_); P.tokw[TOK_W + 2 * c_row + 1] = __float_as_uint(wb_); } \
        } }
    RP_FILL(a, 0); { const int i1 = nj > 1 ? 1 : 0; RP_FILL(b, i1); } RP_PART(a);
    for (int i = 0; i < nj; i += 2) {
        RP_BODY(a, b, i);
        if (i + 1 >= nj) break;
        RP_BODY(b, a, i + 1);
    }
    RP_STORE();
#undef RP_FILL
#undef RP_PART
#undef RP_STORE
#undef RP_BODY
#undef JOF
    __syncthreads();
    if (P.wr) {
        if (tid < 16) { const int e = tid & 7, half = tid >> 3, j0 = half * (rpb >> 1); int c = 0;
            for (int j = j0; j < j0 + (rpb >> 1); ++j) { const int ee = ebuf[j]; const int row = brow0 + GRID * j;
                if ((ee & 255) == e) P.tokw[TOK_POS + 2 * row] = (unsigned)c++; if ((ee >> 8) == e) P.tokw[TOK_POS + 2 * row + 1] = (unsigned)c++; }
            P.tokw[TOK_BLK + (half * GRID + (int)blockIdx.x) * 8 + e] = (unsigned)c;
            if (c) __hip_atomic_fetch_add(P.cnt + half * 64 + e, (unsigned)c, __ATOMIC_RELAXED, __HIP_MEMORY_SCOPE_AGENT);
        }
        __syncthreads();
    }
}

#undef CB
#undef UNPK_LO
#undef UNPK_HI
typedef const __attribute__((address_space(4))) Args* KArgs;
__device__ __forceinline__ KArgs kargs() { unsigned long long p = (unsigned long long)__builtin_amdgcn_kernarg_segment_ptr(); asm volatile("" : "+s"(p)); return (KArgs)p; }

__device__ __forceinline__ void phase_prologue(LAS unsigned char* lds) {
    const KArgs a = kargs(); const int tid = fresh_tid(), lane = tid & 63, wave = __builtin_amdgcn_readfirstlane(tid >> 6);
    const int bid = blockIdx.x, G = gridDim.x; unsigned char* ws = a->ws;
    float* MOD = (float*)(ws + WS_MOD); float* ROPE = (float*)(ws + WS_ROPE);
    {
        LAS float* sc = (LAS float*)lds;
        LAS float* red = (LAS float*)(lds + 81920);
        const float* cc = a->c; const float* cctx = a->c_ctx;
        for (int idx = tid; idx < 17 * 1024; idx += 512) { const int r = idx >> 10, k = idx & 1023; const float v = r < 16 ? cc[r * 1024 + k] : cctx[k]; sc[k * 20 + r] = v / (1.0f + __expf(-v)); }
        __syncthreads();
        const float* wmod = a->w_mod; const float* bmod = a->b_mod;
        for (int item = bid; item < 4 * 96; item += G) {
            const int layer = item / 96, cb = item - layer * 96;
            const float* W = wmod + (size_t)layer * D * NMOD + cb * 64 + lane;
            float acc[17];
#pragma unroll
            for (int r = 0; r < 17; ++r) acc[r] = 0.f;
            for (int kb = 0; kb < 128; kb += 16) {
                float wv[16];
#pragma unroll
                for (int u = 0; u < 16; ++u) wv[u] = W[(size_t)(wave * 128 + kb + u) * NMOD];
#pragma unroll
                for (int u = 0; u < 16; ++u) { const int k = wave * 128 + kb + u; const float w = wv[u];
                    const f32x4 s0 = *(const LAS f32x4*)(sc + k * 20), s1 = *(const LAS f32x4*)(sc + k * 20 + 4), s2 = *(const LAS f32x4*)(sc + k * 20 + 8), s3 = *(const LAS f32x4*)(sc + k * 20 + 12); const float s4 = sc[k * 20 + 16];
#pragma unroll
                    for (int q = 0; q < 4; ++q) { acc[q] += w * s0[q]; acc[4 + q] += w * s1[q]; acc[8 + q] += w * s2[q]; acc[12 + q] += w * s3[q]; }
                    acc[16] += w * s4; } }
#pragma unroll
            for (int r = 0; r < 17; ++r) red[(wave * 17 + r) * 64 + lane] = acc[r];
            __syncthreads();
            for (int idx = tid; idx < 17 * 64; idx += 512) { const int r = idx >> 6, l = idx & 63; float s = 0.f;
#pragma unroll
                for (int w = 0; w < 8; ++w) s += red[(w * 17 + r) * 64 + l];
                MOD[((size_t)layer * 17 + r) * NMOD + cb * 64 + l] = s + bmod[layer * NMOD + cb * 64 + l]; }
            __syncthreads();
        }
    }
    if (bid == G - 1) {
        for (int idx = tid; idx < 1024; idx += 512) { const int pos = idx >> 4, i = idx & 15;
            const float inv = exp2f(-(float)(2 * i) * (13.287712379549449f / 32.0f)); const float ang = (float)pos * inv;
            ROPE[idx] = __cosf(ang); ROPE[1024 + idx] = __sinf(ang); }
        if (wave < 2) { const int j = wave; const float p1 = wave_sum(a->lq1[j * 64 + lane] * a->lk1[j * 64 + lane]), p2 = wave_sum(a->lq2[j * 64 + lane] * a->lk2[j * 64 + lane]);
            const float li = 0.8f - 0.6f * __expf(-0.3f * (float)(2 * j + 1));
            if (lane == 0) ROPE[2048 + j] = __expf(p1) - __expf(p2) + li; }
    }
    __syncthreads();
    {
        LAS float* scr = (LAS float*)(lds + wave * 8448);
        const int gw = bid * 8 + wave, NGW = G * 8; int rot = 0;
        convert_mats(a->a_w_qkv, D, NQA, 2, (bf16_t*)(ws + WS_WAQKV), 0, scr, gw, NGW, rot, lane);
        convert_mats(a->a_w_o, D, D, 2, (bf16_t*)(ws + WS_WAO), 0, scr, gw, NGW, rot, lane);
        convert_mats(a->b_w_qkv, D, NQB, 2, (bf16_t*)(ws + WS_WBQKV), 0, scr, gw, NGW, rot, lane);
        convert_mats(a->b_w_o, D, D, 2, (bf16_t*)(ws + WS_WBO), 0, scr, gw, NGW, rot, lane);
        convert_mats(a->ff_g, D, DFF, 2, (bf16_t*)(ws + WS_WFGU), 1, scr, gw, NGW, rot, lane);
        convert_mats(a->ff_u, D, DFF, 2, (bf16_t*)(ws + WS_WFGU), 2, scr, gw, NGW, rot, lane);
        convert_mats(a->ff_d, DFF, D, 2, (bf16_t*)(ws + WS_WFD), 0, scr, gw, NGW, rot, lane);
        convert_mats(a->moe_g, D, DFE, 16, (bf16_t*)(ws + WS_WMGU), 1, scr, gw, NGW, rot, lane);
        convert_mats(a->moe_u, D, DFE, 16, (bf16_t*)(ws + WS_WMGU), 2, scr, gw, NGW, rot, lane);
        convert_mats(a->moe_d, DFE, D, 16, (bf16_t*)(ws + WS_WMD), 0, scr, gw, NGW, rot, lane);
    }
    __syncthreads();
}

__device__ __forceinline__ void phase_mod0() {
    const KArgs a = kargs(); const int tid = fresh_tid(), lane = tid & 63, wave = __builtin_amdgcn_readfirstlane(tid >> 6);
    const int bid = blockIdx.x; unsigned char* ws = a->ws;
    const float* MOD = (const float*)(ws + WS_MOD); bf16_t* H = (bf16_t*)(ws + WS_H);
    const float* x = a->x; const float* ctx = a->ctx;
    const int rpb = MT / GRID;
    bf16_t* XB = (bf16_t*)(ws + WS_XB);
    for (int jr = wave; jr < rpb; jr += 16) {
        f32x4 xv[2][4]; int mr[2], rw[2];
#pragma unroll
        for (int q = 0; q < 2; ++q) { const int row = bid * rpb + jr + 8 * q; rw[q] = row; const bool lat = row < ML;
            const float* xr = lat ? x + (size_t)row * D : ctx + (size_t)(row - ML) * D; mr[q] = lat ? (row >> 11) : 16;
#pragma unroll
            for (int p = 0; p < 2; ++p) { xv[q][2 * p] = *(const f32x4*)(xr + 8 * lane + 512 * p); xv[q][2 * p + 1] = *(const f32x4*)(xr + 8 * lane + 512 * p + 4); } }
#pragma unroll
        for (int q = 0; q < 2; ++q)
#pragma unroll
            for (int p = 0; p < 2; ++p) { const int c8 = 8 * lane + 512 * p;
                const f32x4 sca = *(const f32x4*)(MOD + (size_t)mr[q] * NMOD + D + c8), scb = *(const f32x4*)(MOD + (size_t)mr[q] * NMOD + D + c8 + 4);
                const f32x4 sha = *(const f32x4*)(MOD + (size_t)mr[q] * NMOD + c8), shb = *(const f32x4*)(MOD + (size_t)mr[q] * NMOD + c8 + 4);
                const f32x4 xa = xv[q][2 * p], xb = xv[q][2 * p + 1];
                const f32x4 ha = xa * (sca + 1.0f) + sha, hb = xb * (scb + 1.0f) + shb;
                u32x4 w; w.x = cvt_pk_bf16(ha[0], ha[1]); w.y = cvt_pk_bf16(ha[2], ha[3]); w.z = cvt_pk_bf16(hb[0], hb[1]); w.w = cvt_pk_bf16(hb[2], hb[3]);
                *(u32x4*)(H + (size_t)rw[q] * D + c8) = w;
                u32x4 xw; xw.x = cvt_pk_bf16(xa[0], xa[1]); xw.y = cvt_pk_bf16(xa[2], xa[3]); xw.z = cvt_pk_bf16(xb[0], xb[1]); xw.w = cvt_pk_bf16(xb[2], xb[3]);
                *(u32x4*)(XB + (size_t)rw[q] * D + c8) = xw; }
    }
}

__device__ __forceinline__ void phase_qkv(LAS unsigned char* lds, int layer) {
    const KArgs a = kargs(); unsigned char* ws = a->ws;
    const bool typeB = layer & 1; const int j2 = layer >> 1; const int NQ = typeB ? NQB : NQA;
    const float* ROPE = (const float*)(ws + WS_ROPE);
    LAS float* rl = (LAS float*)(lds + RING_BYTES);
    { const int tid = fresh_tid(); *(LAS f32x4*)(rl + 4 * tid) = *(const f32x4*)(ROPE + 4 * tid); }
    __syncthreads();
    pg8::Gemm g{(const bf16_t*)(ws + WS_H), typeB ? (const bf16_t*)(ws + WS_WBQKV) + (size_t)j2 * NQB * D : (const bf16_t*)(ws + WS_WAQKV) + (size_t)j2 * NQA * D, D};
    pg8::GroupOrder S; S.init(MT / 256, NQ / 256, gridDim.x, blockIdx.x, D / 64);
    pg8::EpiQKV E{(bf16_t*)(ws + WS_BIG), NQ, typeB ? 8 : 5, 4, ML / 256, rl, rl + 1024};
    pg8::gemm_phase<pg8::EpiQKV, pg8::GroupOrder>(lds, g, S, E);
}

__device__ __forceinline__ void phase_attn(LAS unsigned char* lds, int layer) {
    const KArgs a = kargs(); unsigned char* ws = a->ws;
    const int tid = fresh_tid(); const int wave = __builtin_amdgcn_readfirstlane(tid >> 6);
    const bool typeB = layer & 1; const int j2 = layer >> 1; const bool with_ctx = layer < DEPTH - 1;
    const int bid = blockIdx.x; const int x8 = bid & 7, y = bid >> 3;
    const bf16_t* QKV = (const bf16_t*)(ws + WS_BIG); bf16_t* O = (bf16_t*)(ws + WS_H);
    const int sub = wave >> 2, w4 = wave & 3;
    if (!typeB) {
        const float* sink = a->a_sink;
        const int nu = with_ctx ? 9 : 8;
        auto mk = [&](int i, att::UnitD& U) { int b, p, n;
            if (i < 8) { const int bp = i * 16 + x8 * 2 + (y >> 4); b = bp >> 3; p = bp & 7; n = (y + 2 * i) & 15;
                const int j0 = n == 0 ? 2 : 0, j1 = n == 15 ? 4 : 6;
                U.qrow0 = b * SEQ + n * 128; U.n1 = 4; U.base1 = ML + b * CTXL; U.n2 = j1 - j0; U.base2 = b * SEQ + (n - 1) * 128 + 64 * j0;
                U.kp0 = (n - 1) * 128 + 64 * j0; U.qp0 = n * 128 + w4 * 32; U.masked = 1;
            } else { b = bid >> 4; p = (bid >> 1) & 7; n = bid & 1;
                U.qrow0 = ML + b * CTXL + n * 128; U.n1 = 4; U.base1 = ML + b * CTXL; U.n2 = 0; U.base2 = 0; U.kp0 = 0; U.qp0 = 0; U.masked = 0; }
            const int head = 2 * p + sub;
            U.qcol = head * 64; U.kcol = 1024 + (p >> 1) * 64; U.vcol = 1280 + (p >> 1) * 64; U.ocol = head * 64;
            U.sink2 = sink[j2 * 16 + head] * LOG2E; U.use_sink = 1; U.diag = nullptr; };
        att::UnitD Ua, Ub; mk(0, Ua);
        for (int i = 0; i < nu; ++i) { const bool hn = i + 1 < nu; mk(hn ? i + 1 : i, Ub);
            att::attn_unit<false>(lds, QKV, NQA, O, Ua, Ub, hn, i > 0, 0.f, 0.f, nullptr);
            Ua = Ub; }
    } else {
        const float lam = ((const float*)(ws + WS_ROPE))[2048 + j2];
        const float post = 1.0f - (0.8f - 0.6f * __expf(-0.3f * (float)layer));
        const float* subln = a->subln + j2 * 128;
        const int nu = with_ctx ? 9 : 8;
        auto mk = [&](int i, att::UnitD& U) { int b, p, n;
            if (i < 8) { const int bp = i * 16 + x8 * 2 + (y >> 4); b = bp >> 3; p = bp & 7; n = y & 15;
                U.qrow0 = b * SEQ + n * 128; U.n1 = 32; U.base1 = b * SEQ; U.n2 = 4; U.base2 = ML + b * CTXL;
            } else { b = bid >> 4; p = (bid >> 1) & 7; n = bid & 1;
                U.qrow0 = ML + b * CTXL + n * 128; U.n1 = 4; U.base1 = ML + b * CTXL; U.n2 = 0; U.base2 = 0; }
            U.kp0 = 0; U.qp0 = 0; U.masked = 0; U.sink2 = 0.f; U.use_sink = 0; U.diag = (DIAG_SEL && bid == 0 && i == 3 && layer == 1) ? (unsigned*)(ws + WS_CTL) + 16384 : nullptr;
            U.qcol = (2 * p + sub) * 64; U.kcol = 1024 + 2 * p * 64; U.vcol = 2048 + p * 128; U.ocol = p * 128; };
        att::UnitD Ua, Ub; mk(0, Ua);
        for (int i = 0; i < nu; ++i) { const bool hn = i + 1 < nu; mk(hn ? i + 1 : i, Ub);
            att::attn_unit<true>(lds, QKV, NQB, O, Ua, Ub, hn, i > 0, lam, post, subln);
            Ua = Ub; }
    }
    __syncthreads();
}

__device__ __forceinline__ void phase_oproj(LAS unsigned char* lds, int layer) {
    const KArgs a = kargs(); unsigned char* ws = a->ws;
    const bool typeB = layer & 1; const int j2 = layer >> 1; const int rows_out = (layer < DEPTH - 1) ? MT : ML;
    pg8::Gemm g{(const bf16_t*)(ws + WS_H), typeB ? (const bf16_t*)(ws + WS_WBO) + (size_t)j2 * D * D : (const bf16_t*)(ws + WS_WAO) + (size_t)j2 * D * D, D};
    pg8::GroupOrder S; S.init(rows_out / 256, D / 256, gridDim.x, blockIdx.x, D / 64, NSPLIT_TILE0);
    pg8::EpiBf16 E{(bf16_t*)(ws + WS_BIG), D, (bf16_t*)(ws + WS_PARTS) - (size_t)SPLIT_ROW0 * D, PART_STRIDE};
    pg8::gemm_phase<pg8::EpiBf16, pg8::GroupOrder>(lds, g, S, E);
}

__device__ __forceinline__ void phase_ln1(LAS unsigned char* lds, int layer, bool dummy = false) {
    const KArgs a = kargs(); unsigned char* ws = a->ws;
    const int tid = fresh_tid(), lane = tid & 63, wave = __builtin_amdgcn_readfirstlane(tid >> 6);
    const bool typeB = layer & 1; const int j2 = layer >> 1; const int rows_out = (layer < DEPTH - 1) ? MT : ML;
    const float* modL = (const float*)(ws + WS_MOD) + (size_t)layer * 17 * NMOD;
    RowP P; P.xin_b = (const bf16_t*)(ws + WS_XB); P.xout_b = (bf16_t*)(ws + WS_XB); P.xout_f = nullptr;
    P.F = (const bf16_t*)(ws + WS_BIG); P.Fp = (const bf16_t*)(ws + WS_PARTS) - (size_t)SPLIT_ROW0 * D; P.mod_gate = modL + 2 * D; P.lg = a->ln_g + (layer * 2 + 0) * D; P.lb = a->ln_b + (layer * 2 + 0) * D;
    P.mod_sc = modL + 4 * D; P.mod_sh = modL + 3 * D; P.H = (bf16_t*)(ws + WS_H); P.tok = nullptr; P.two = 0;
    P.wr = typeB ? a->moe_r + (size_t)j2 * D * 8 : nullptr; P.cnt = (unsigned*)(ws + WS_CTL) + CW_CNT + j2 * 128; P.tokw = (unsigned*)(ws + WS_TOK);
    if (dummy) { P.wr = nullptr; P.xout_b = (bf16_t*)(ws + WS_END); P.H = (bf16_t*)(ws + WS_END); }
    row_phase<false, false>(P, 0, rows_out, lds, tid, lane, wave, rows_out / 2);
}

__device__ __forceinline__ void tile_starts(const unsigned char* ws, bool typeB, int j2, int half, int hrows, int (&ts)[9]) {
    ts[0] = 0;
    if (typeB) { const unsigned* cnt = (const unsigned*)(ws + WS_CTL) + CW_CNT + j2 * 128 + half * 64;
#pragma unroll
        for (int e = 0; e < 8; ++e) ts[e + 1] = ts[e] + (int)((__builtin_amdgcn_readfirstlane(cnt[e]) + 255u) >> 8);
    } else {
#pragma unroll
        for (int e = 0; e < 8; ++e) ts[e + 1] = hrows / 256; }
}

__device__ __forceinline__ void phase_gather(LAS unsigned char* lds, int layer, int half) {
    const KArgs a = kargs(); unsigned char* ws = a->ws;
    const int tid = fresh_tid(), lane = tid & 63, wave = __builtin_amdgcn_readfirstlane(tid >> 6);
    const int j2 = layer >> 1; const int rows_out = (layer < DEPTH - 1) ? MT : ML; const int hrows = rows_out / 2, row_lo = half * hrows;
    int ts[9]; tile_starts(ws, true, j2, half, hrows, ts);
    unsigned* TOK = (unsigned*)(ws + WS_TOK); const bf16_t* H = (const bf16_t*)(ws + WS_H); bf16_t* HG = (bf16_t*)(ws + (half ? WS_HG1 : WS_BIG));
    const int rpb = hrows / GRID;
    LAS unsigned* bs = (LAS unsigned*)lds;
    { const int bb = (int)blockIdx.x;
      if (wave == 0) { unsigned a8[8];
#pragma unroll
          for (int e = 0; e < 8; ++e) a8[e] = 0u;
#pragma unroll
          for (int k = 0; k < 4; ++k) { const int b = lane + 64 * k; const u32x4 c0 = *(const u32x4*)(TOK + TOK_BLK + (half * GRID + b) * 8), c1 = *(const u32x4*)(TOK + TOK_BLK + (half * GRID + b) * 8 + 4);
              if (b < bb) { a8[0] += c0.x; a8[1] += c0.y; a8[2] += c0.z; a8[3] += c0.w; a8[4] += c1.x; a8[5] += c1.y; a8[6] += c1.z; a8[7] += c1.w; } }
#pragma unroll
          for (int e = 0; e < 8; ++e) {
              a8[e] = wave_allsum_u(a8[e]);
              if (lane == 0) bs[e] = a8[e]; } }
      __syncthreads(); }
    unsigned base8[8];
#pragma unroll
    for (int e = 0; e < 8; ++e) base8[e] = bs[e];
    unsigned short* RIDX = (unsigned short*)(ws + WS_CTL + CTL_RIDX) + (size_t)half * RIDX_HALF;
    for (int jr = tid; jr < rpb; jr += 512) {
        const int row = row_lo + (int)blockIdx.x + GRID * jr;
        const unsigned ee = TOK[TOK_E + row]; const int e1 = ee & 255, e2 = ee >> 8;
        int t1 = 0, t2 = 0;
#pragma unroll
        for (int e = 0; e < 8; ++e) { t1 = (e1 == e) ? ts[e] * 256 + (int)base8[e] : t1; t2 = (e2 == e) ? ts[e] * 256 + (int)base8[e] : t2; }
        const int s1 = t1 + (int)TOK[TOK_POS + 2 * row], s2 = t2 + (int)TOK[TOK_POS + 2 * row + 1];
        TOK[TOK_SLOT + 2 * row] = (unsigned)s1; TOK[TOK_SLOT + 2 * row + 1] = (unsigned)s2;
        RIDX[s1] = (unsigned short)row; RIDX[s2] = (unsigned short)row; }
}

__device__ __forceinline__ void phase_gu(LAS unsigned char* lds, int layer, int half) {
    const KArgs a = kargs(); unsigned char* ws = a->ws;
    const bool typeB = layer & 1; const int j2 = layer >> 1; const int rows_out = (layer < DEPTH - 1) ? MT : ML; const int hrows = typeB ? rows_out / 2 : rows_out;
    int ts[9]; tile_starts(ws, typeB, j2, half, hrows, ts);
    const int dff = typeB ? DFE : DFF;
    pg8::Gemm g{(const bf16_t*)(ws + WS_H), typeB ? (const bf16_t*)(ws + WS_WMGU) + (size_t)j2 * NEXP * 2 * DFE * D : (const bf16_t*)(ws + WS_WFGU) + (size_t)j2 * 2 * DFF * D, D};
    pg8::GroupOrder S; S.init(ts[8], 2 * dff / 256, gridDim.x, blockIdx.x, D / 64);
    pg8::EpiSwiglu E{(bf16_t*)(ws + WS_HID), dff};
    if (typeB) { S.ts1 = ts[1]; S.ts2 = ts[2]; S.ts3 = ts[3]; S.ts4 = ts[4]; S.ts5 = ts[5]; S.ts6 = ts[6]; S.ts7 = ts[7];
        pg8::gemm_phase<pg8::EpiSwiglu, pg8::GroupOrder, true>(lds, g, S, E, (const unsigned short*)(ws + WS_CTL + CTL_RIDX) + (size_t)half * RIDX_HALF);
    } else pg8::gemm_phase<pg8::EpiSwiglu, pg8::GroupOrder, false>(lds, g, S, E);
}

__device__ __forceinline__ void phase_down(LAS unsigned char* lds, int layer, int half) {
    const KArgs a = kargs(); unsigned char* ws = a->ws;
    const bool typeB = layer & 1; const int j2 = layer >> 1; const int rows_out = (layer < DEPTH - 1) ? MT : ML; const int hrows = typeB ? rows_out / 2 : rows_out;
    int ts[9]; tile_starts(ws, typeB, j2, half, hrows, ts);
    const int dff = typeB ? DFE : DFF;
    pg8::Gemm g{(const bf16_t*)(ws + WS_HID), typeB ? (const bf16_t*)(ws + WS_WMD) + (size_t)j2 * NEXP * D * DFE : (const bf16_t*)(ws + WS_WFD) + (size_t)j2 * D * DFF, dff};
    pg8::GroupOrder S; S.init(ts[8], D / 256, gridDim.x, blockIdx.x, dff / 64, NSPLIT_TILE0);
    if (typeB) { S.ts1 = ts[1]; S.ts2 = ts[2]; S.ts3 = ts[3]; S.ts4 = ts[4]; S.ts5 = ts[5]; S.ts6 = ts[6]; S.ts7 = ts[7]; }
    pg8::EpiBf16 E{(bf16_t*)(ws + WS_BIG), D, (bf16_t*)(ws + WS_PARTS) - (size_t)SPLIT_ROW0 * D, PART_STRIDE};
    pg8::gemm_phase<pg8::EpiBf16, pg8::GroupOrder>(lds, g, S, E);
}

__device__ __forceinline__ void phase_ln2(LAS unsigned char* lds, int layer, int half, bool dummy = false) {
    const KArgs a = kargs(); unsigned char* ws = a->ws;
    const int tid = fresh_tid(), lane = tid & 63, wave = __builtin_amdgcn_readfirstlane(tid >> 6);
    const bool typeB = layer & 1; const int rows_out = (layer < DEPTH - 1) ? MT : ML; const int hrows = typeB ? rows_out / 2 : rows_out;
    const float* modL = (const float*)(ws + WS_MOD) + (size_t)layer * 17 * NMOD; const float* modN = modL + 17 * NMOD;
    RowP P; P.xin_b = (const bf16_t*)(ws + WS_XB); const bool lastsub = layer + 1 == DEPTH; P.xout_b = lastsub ? nullptr : (bf16_t*)(ws + WS_XB); P.xout_f = a->out;
    P.F = (const bf16_t*)(ws + WS_BIG); P.Fp = (const bf16_t*)(ws + WS_PARTS) - (size_t)SPLIT_ROW0 * D; P.mod_gate = modL + 5 * D; P.lg = a->ln_g + (layer * 2 + 1) * D; P.lb = a->ln_b + (layer * 2 + 1) * D;
    const bool nextmod = layer + 1 < DEPTH;
    P.mod_sc = nextmod ? modN + D : nullptr; P.mod_sh = nextmod ? modN : nullptr; P.H = (bf16_t*)(ws + WS_H); P.tok = (const unsigned*)(ws + WS_TOK); P.two = typeB ? 1 : 0;
    P.wr = nullptr; P.cnt = nullptr; P.tokw = nullptr;
    if (dummy) { P.xout_b = (bf16_t*)(ws + WS_END); P.H = (bf16_t*)(ws + WS_END); }
    if (!typeB) row_phase<false, false>(P, half * hrows, hrows, lds, tid, lane, wave, hrows);
    else if (nextmod) row_phase<true, false>(P, half * hrows, hrows, lds, tid, lane, wave, hrows);
    else row_phase<true, true>(P, half * hrows, hrows, lds, tid, lane, wave, hrows);
}

__global__ void __launch_bounds__(512, 2) dit_fwd(Args a_unused) {
    extern __shared__ __attribute__((aligned(16))) unsigned char lds_raw[];
    LAS unsigned char* lds = (LAS unsigned char*)lds_raw;
    volatile LAS unsigned* MISC = (volatile LAS unsigned*)(lds + MISC_OFF);
    for (int u = threadIdx.x; u < (LDS_BYTES - LDSCTL_OFF) / 4; u += 512) ((LAS unsigned*)(lds + LDSCTL_OFF))[u] = 0u;
    __syncthreads();
    int ph_lo, ph_hi;
    XcdBarrier bar;
    { const KArgs a = kargs(); ph_lo = a->ph_lo; ph_hi = a->ph_hi; bar = xcd_barrier_post((unsigned*)(a->ws + WS_CTL) + CW_BAR, MISC + 8); }
    int ph = 0; unsigned long long dbar = 0;
#define PH_ON (ph >= ph_lo && ph < ph_hi)
#define PH_END do { const bool _both = (ph >= ph_lo) && (ph + 1 < ph_hi); ++ph; if (_both) { unsigned long long _b0 = 0; if (DIAG_SEL >= 12) _b0 = __builtin_amdgcn_s_memrealtime(); xcd_barrier(bar); if (DIAG_SEL >= 12) dbar += __builtin_amdgcn_s_memrealtime() - _b0; if (PROBE_MASK & 32) xcd_barrier(bar); } } while (0)
    if (PH_ON) { phase_prologue(lds); if (PROBE_MASK & 16) phase_prologue(lds); }
    PH_END;
    if (PH_ON) { phase_mod0(); if (PROBE_MASK & 64) phase_mod0(); }
    PH_END;
    for (int layer = 0; layer < DEPTH; ++layer) {
        if (PH_ON) { phase_qkv(lds, layer); if (PROBE_MASK & 1) phase_qkv(lds, layer); }
        PH_END;
        if (PH_ON) { phase_attn(lds, layer); if ((PROBE_MASK & 8) || ((PROBE_MASK & 128) && (layer & 1)) || ((PROBE_MASK & 256) && !(layer & 1))) phase_attn(lds, layer); }
        PH_END;
        if (PH_ON) { phase_oproj(lds, layer); if (PROBE_MASK & 1) phase_oproj(lds, layer); }
        PH_END;
        if (PH_ON) { phase_ln1(lds, layer); if (PROBE_MASK & 64) phase_ln1(lds, layer, true); }
        PH_END;
        if (!(layer & 1)) {
            if (PH_ON) { phase_gu(lds, layer, 0); if (PROBE_MASK & 2) phase_gu(lds, layer, 0); }
            PH_END;
            if (PH_ON) { phase_down(lds, layer, 0); if (PROBE_MASK & 4) phase_down(lds, layer, 0); }
            PH_END;
            if (PH_ON) { phase_ln2(lds, layer, 0); if (PROBE_MASK & 64) phase_ln2(lds, layer, 0, true); }
            PH_END;
        } else {
            if (PH_ON) { phase_gather(lds, layer, 0); __syncthreads(); phase_gather(lds, layer, 1); }
            PH_END;
            if (PH_ON) phase_gu(lds, layer, 0);
            PH_END;
            if (PH_ON) phase_down(lds, layer, 0);
            PH_END;
            if (PH_ON) { if (blockIdx.x & 1) { phase_gu(lds, layer, 1); phase_ln2(lds, layer, 0); } else { phase_ln2(lds, layer, 0); phase_gu(lds, layer, 1); } }
            PH_END;
            if (PH_ON) phase_down(lds, layer, 1);
            PH_END;
            if (PH_ON) phase_ln2(lds, layer, 1);
            PH_END;
        }
    }
#undef PH_ON
#undef PH_END
    if (DIAG_SEL >= 12 && threadIdx.x == 0 && (blockIdx.x == (DIAG_SEL == 12 ? 0 : (DIAG_SEL == 13 ? 100 : 255)))) { const KArgs a = kargs(); __hip_atomic_store((unsigned*)(a->ws + WS_CTL) + 16384 + DIAG_SEL, (unsigned)(dbar >> 3), __ATOMIC_RELAXED, __HIP_MEMORY_SCOPE_AGENT); }
    if (DIAG_SEL >= 12) { __syncthreads(); if (blockIdx.x == 0) { xcd_barrier(bar); } else xcd_barrier(bar); }
    if (DIAG_SEL && blockIdx.x == 0 && threadIdx.x == 0) { const KArgs a = kargs(); const unsigned d = __hip_atomic_load((unsigned*)(a->ws + WS_CTL) + 16384 + DIAG_SEL, __ATOMIC_RELAXED, __HIP_MEMORY_SCOPE_AGENT);
        const unsigned long long t0 = __builtin_amdgcn_s_memrealtime(); while (__builtin_amdgcn_s_memrealtime() - t0 < 16ull * d) __builtin_amdgcn_s_sleep(8); }
}

constexpr int NPHASES = 2 + 2 * (4 + 3) + 2 * (4 + 6);

extern "C" void kernel_launch(void* const* d_in, const int* in_sizes, int n_in, void* d_out, int out_size, void* d_ws, size_t ws_size, hipStream_t stream) {
    static int ready = 0;
    if (ready == 0) {
        if (n_in != 25 || out_size != ML * D || ws_size < WS_END) { fprintf(stderr, "kernel_launch: unexpected shapes (n_in %d out %d ws %zu); nothing launched\n", n_in, out_size, ws_size); ready = -1; return; }
        int dev = 0, cus = 0, per_cu = 0;
        if (hipGetDevice(&dev) != hipSuccess || hipDeviceGetAttribute(&cus, hipDeviceAttributeMultiprocessorCount, dev) != hipSuccess) { ready = -1; return; }
        if (hipFuncSetAttribute((const void*)dit_fwd, hipFuncAttributeMaxDynamicSharedMemorySize, LDS_BYTES) != hipSuccess) { fprintf(stderr, "kernel_launch: hipFuncSetAttribute failed\n"); ready = -1; return; }
        if (hipOccupancyMaxActiveBlocksPerMultiprocessor(&per_cu, (const void*)dit_fwd, 512, LDS_BYTES) != hipSuccess || per_cu < 1) fprintf(stderr, "kernel_launch: occupancy query reports %d\n", per_cu);
        (void)hipGetLastError();
        if (cus < GRID) { fprintf(stderr, "kernel_launch: %d CUs < %d; nothing launched\n", cus, GRID); ready = -1; return; }
        ready = 1;
    }
    if (ready < 0) return;
    if (hipMemsetAsync((char*)d_ws + WS_CTL, 0, CTL_ZERO_BYTES, stream) != hipSuccess) return;
    Args a{};
    a.x = (const float*)d_in[0]; a.c = (const float*)d_in[1]; a.ctx = (const float*)d_in[2]; a.c_ctx = (const float*)d_in[3]; a.w_mod = (const float*)d_in[4]; a.b_mod = (const float*)d_in[5];
    a.ln_g = (const float*)d_in[6]; a.ln_b = (const float*)d_in[7]; a.a_w_qkv = (const float*)d_in[8]; a.a_sink = (const float*)d_in[9]; a.a_w_o = (const float*)d_in[10];
    a.b_w_qkv = (const float*)d_in[11]; a.lq1 = (const float*)d_in[12]; a.lk1 = (const float*)d_in[13]; a.lq2 = (const float*)d_in[14]; a.lk2 = (const float*)d_in[15];
    a.subln = (const float*)d_in[16]; a.b_w_o = (const float*)d_in[17]; a.ff_g = (const float*)d_in[18]; a.ff_u = (const float*)d_in[19]; a.ff_d = (const float*)d_in[20];
    a.moe_r = (const float*)d_in[21]; a.moe_g = (const float*)d_in[22]; a.moe_u = (const float*)d_in[23]; a.moe_d = (const float*)d_in[24];
    a.out = (float*)d_out; a.ws = (unsigned char*)d_ws;
#if MK_LAUNCH_MODE == 0
    a.ph_lo = 0; a.ph_hi = NPHASES;
    hipLaunchKernelGGL(dit_fwd, dim3(GRID), dim3(512), LDS_BYTES, stream, a);
#else
    for (int k = 0; k < NPHASES; ++k) { a.ph_lo = k; a.ph_hi = k + 1; hipLaunchKernelGGL(dit_fwd, dim3(GRID), dim3(512), LDS_BYTES, stream, a); }
#endif
    const hipError_t le = hipPeekAtLastError();
    if (le != hipSuccess) fprintf(stderr, "kernel_launch: launch failed: %s\n", hipGetErrorName(le));
}
```
